# Optimizing an MI355X kernel written in HIP

```python
import math
import jax
import jax.numpy as jnp
from jax import lax
import numpy as np

D_MODEL = 1024
BATCH = 8
SEQ = 2048
DEPTH = 4
DEC_BATCH = 128
DEC_SEQ = 4
PAST_LEN = 16384
PAGE_SIZE = 128

N_EVEN = (DEPTH + 1) // 2
N_ODD = DEPTH // 2
D_A = D_MODEL // 2
S5_GROUP = 16
G_A = D_A // S5_GROUP
S5_STATE = 64
D_B = D_MODEL // 2
H_B = 8
HD_B = D_B // H_B
CHUNK = 128
D_IN_EVEN = D_A + 2 * D_B
D_C = D_MODEL // 2
POOL_WINDOWS = (2, 4, 8, 16)
N_POOL = len(POOL_WINDOWS)
C_GROUP = D_C // N_POOL
POOL_BUF = max(POOL_WINDOWS) - 1
D_D = D_MODEL // 2
CONV_W = 3
D_IN_ODD = D_C + 3 * D_D
D_FF = ((8 * D_MODEL // 3 + 255) // 256) * 256
EPS = 1e-6

kernel_name = 'hybrid_s5_gmlp_pool_conv_decoder_step'


def rmsnorm(x, g):
    xf = x.astype(jnp.float32)
    y = xf * lax.rsqrt(jnp.mean(xf * xf, axis=-1, keepdims=True) + EPS)
    return (y * g.astype(jnp.float32)).astype(x.dtype)


def swiglu(x, w_gate, w_up, w_down):
    return (jax.nn.silu(x @ w_gate) * (x @ w_up)) @ w_down


def _complex_affine_combine(e1, e2):
    a1r, a1i, b1r, b1i = e1
    a2r, a2i, b2r, b2i = e2
    return (a2r * a1r - a2i * a1i,
            a2r * a1i + a2i * a1r,
            a2r * b1r - a2i * b1i + b2r,
            a2r * b1i + a2i * b1r + b2i)


def s5_mixer(u, h0_re, h0_im, lam_re, lam_im, log_dt, b_re, b_im, c_re, c_im, d_skip, glu_w, glu_b):
    f32 = jnp.float32
    bsz, l, _ = u.shape
    ug = u.astype(f32).reshape(bsz, l, G_A, S5_GROUP)
    lr = lam_re.astype(f32)
    li = lam_im.astype(f32)
    dt = jnp.exp(log_dt.astype(f32))[:, None]
    mag = jnp.exp(lr * dt)
    ang = li * dt
    ab_re = mag * jnp.cos(ang)
    ab_im = mag * jnp.sin(ang)
    den = lr * lr + li * li
    f_re = ((ab_re - 1.0) * lr + ab_im * li) / den
    f_im = (ab_im * lr - (ab_re - 1.0) * li) / den
    br = b_re.astype(f32)
    bi = b_im.astype(f32)
    bb_re = f_re[..., None] * br - f_im[..., None] * bi
    bb_im = f_re[..., None] * bi + f_im[..., None] * br
    x_re = jnp.einsum('blgp,gnp->blgn', ug, bb_re)
    x_im = jnp.einsum('blgp,gnp->blgn', ug, bb_im)
    a_re = jnp.broadcast_to(ab_re, x_re.shape)
    a_im = jnp.broadcast_to(ab_im, x_im.shape)
    p_re, p_im, s_re, s_im = lax.associative_scan(_complex_affine_combine, (a_re, a_im, x_re, x_im), axis=1)
    h0r = h0_re.astype(f32)[:, None]
    h0i = h0_im.astype(f32)[:, None]
    h_re = p_re * h0r - p_im * h0i + s_re
    h_im = p_re * h0i + p_im * h0r + s_im
    y = (jnp.einsum('blgn,gpn->blgp', h_re, c_re.astype(f32))
         - jnp.einsum('blgn,gpn->blgp', h_im, c_im.astype(f32))
         + d_skip.astype(f32) * ug)
    y = y.reshape(bsz, l, D_A)
    z = jax.nn.gelu(y)
    out = z * jax.nn.sigmoid(z @ glu_w.astype(f32) + glu_b.astype(f32))
    return out.astype(u.dtype), h_re[:, -1].astype(h0_re.dtype), h_im[:, -1].astype(h0_im.dtype)


def sgu_mixer(u, v, norm_g, w_s, b_s):
    vn = rmsnorm(v, norm_g)
    bsz, l, _ = u.shape
    cl = min(l, CHUNK)
    nch = l // cl
    mask = jnp.tril(jnp.ones((cl, cl), dtype=bool))
    w = jnp.where(mask, w_s[:, :cl, :cl], 0)
    vc = vn.reshape(bsz, nch, cl, H_B, HD_B)
    mixed = jnp.einsum('hij,bcjhd->bcihd', w, vc) + b_s[:, :cl].T[None, None, :, :, None]
    return u * mixed.reshape(bsz, l, D_B), vn


def pool_mixer(xc, buf, prefix_valid, pool_w, pool_scale):
    f32 = jnp.float32
    bsz, l, _ = xc.shape
    full = jnp.concatenate([buf.astype(xc.dtype), xc], axis=1)
    cs = jnp.pad(jnp.cumsum(full.astype(f32), axis=1), ((0, 0), (1, 0), (0, 0)))
    valid = jnp.concatenate([jnp.full((POOL_BUF,), prefix_valid, f32), jnp.ones((l,), f32)])
    cnt = jnp.pad(jnp.cumsum(valid), (1, 0))
    end = POOL_BUF + 1
    groups = []
    for gi, w in enumerate(POOL_WINDOWS):
        lo, hi = gi * C_GROUP, (gi + 1) * C_GROUP
        s = cs[:, end:end + l, lo:hi] - cs[:, end - w:end - w + l, lo:hi]
        n = cnt[end:end + l] - cnt[end - w:end - w + l]
        groups.append(s / n[None, :, None])
    pooled = jnp.concatenate(groups, axis=-1)
    diff = (pooled - xc.astype(f32)).reshape(bsz, l, N_POOL, C_GROUP)
    y = jnp.einsum('blgc,gcd->blgd', diff, pool_w.astype(f32)).reshape(bsz, l, D_C) * pool_scale.astype(f32)
    return y.astype(xc.dtype), full[:, -POOL_BUF:]


def conv_mixer(xd, b_gate, c_gate, buf, conv_w, conv_b):
    z = c_gate * xd
    l = z.shape[1]
    full = jnp.concatenate([buf.astype(z.dtype), z], axis=1)
    conv = conv_b
    for k in range(CONV_W):
        conv = conv + full[:, k:k + l] * conv_w[k]
    return b_gate * conv, full[:, -(CONV_W - 1):]


def run_trunk(x, s5_re, s5_im, pool_buf, conv_buf, prefix_valid, W):
    h = x
    new_re, new_im, new_v, new_pool, new_conv = [], [], [], [], []
    for layer in range(DEPTH):
        i = layer // 2
        hn = rmsnorm(h, W['norm_mix'][layer])
        if layer % 2 == 0:
            proj = hn @ W['w_in_even'][i]
            u_a = proj[..., :D_A]
            u_b = proj[..., D_A:D_A + D_B]
            v_b = proj[..., D_A + D_B:]
            y_a, hr, hi = s5_mixer(u_a, s5_re[i], s5_im[i], W['s5_lambda_re'][i], W['s5_lambda_im'][i],
                                   W['s5_log_dt'][i], W['s5_b_re'][i], W['s5_b_im'][i], W['s5_c_re'][i],
                                   W['s5_c_im'][i], W['s5_d'][i], W['s5_glu_w'][i], W['s5_glu_b'][i])
            y_b, vn = sgu_mixer(u_b, v_b, W['sgu_norm'][i], W['sgu_w'][i], W['sgu_b'][i])
            mix = jnp.concatenate([y_a, y_b], axis=-1) @ W['w_out_even'][i]
            new_re.append(hr)
            new_im.append(hi)
            new_v.append(vn)
        else:
            proj = hn @ W['w_in_odd'][i]
            x_c = proj[..., :D_C]
            x_d = proj[..., D_C:D_C + D_D]
            b_g = proj[..., D_C + D_D:D_C + 2 * D_D]
            c_g = proj[..., D_C + 2 * D_D:]
            y_c, nb_pool = pool_mixer(x_c, pool_buf[i], prefix_valid, W['pool_w'][i], W['pool_scale'][i])
            y_d, nb_conv = conv_mixer(x_d, b_g, c_g, conv_buf[i], W['conv_w'][i], W['conv_b'][i])
            mix = jnp.concatenate([y_c, y_d], axis=-1) @ W['w_out_odd'][i]
            new_pool.append(nb_pool)
            new_conv.append(nb_conv)
        h = h + mix
        h = h + swiglu(rmsnorm(h, W['norm_ffn'][layer]), W['ffn_w_gate'][layer], W['ffn_w_up'][layer],
                       W['ffn_w_down'][layer])
    y = rmsnorm(h, W['norm_final'])
    return y, jnp.stack(new_re), jnp.stack(new_im), jnp.stack(new_v), jnp.stack(new_pool), jnp.stack(new_conv)


def setup_inputs(seed: int = 0) -> dict:
    key = jax.random.key(seed)
    keys = jax.random.split(key, 40)
    f32 = jnp.float32

    def nrm(idx, shape, scale):
        return scale * jax.random.normal(keys[idx], shape, f32)

    n_idx = jnp.arange(S5_STATE, dtype=f32)
    return {
        'x_prompt': nrm(0, (BATCH, SEQ, D_MODEL), 1.0),
        'x_sample': nrm(1, (DEC_BATCH, DEC_SEQ, D_MODEL), 1.0),
        'state_s5_re': nrm(2, (N_EVEN, DEC_BATCH, G_A, S5_STATE), 0.5),
        'state_s5_im': nrm(3, (N_EVEN, DEC_BATCH, G_A, S5_STATE), 0.5),
        'state_pool': nrm(4, (N_ODD, DEC_BATCH, POOL_BUF, D_C), 1.0),
        'state_conv': nrm(5, (N_ODD, DEC_BATCH, CONV_W - 1, D_D), 0.5),
        'norm_mix': 1.0 + nrm(6, (DEPTH, D_MODEL), 0.02),
        'norm_ffn': 1.0 + nrm(7, (DEPTH, D_MODEL), 0.02),
        'norm_final': 1.0 + nrm(8, (D_MODEL,), 0.02),
        'w_in_even': nrm(9, (N_EVEN, D_MODEL, D_IN_EVEN), D_MODEL ** -0.5),
        'w_out_even': nrm(10, (N_EVEN, D_A + D_B, D_MODEL), (D_A + D_B) ** -0.5),
        's5_lambda_re': -0.5 + nrm(11, (N_EVEN, G_A, S5_STATE), 0.01),
        's5_lambda_im': jnp.broadcast_to(math.pi * n_idx, (N_EVEN, G_A, S5_STATE)) + nrm(12, (N_EVEN, G_A, S5_STATE), 0.01),
        's5_log_dt': jax.random.uniform(keys[13], (N_EVEN, G_A), f32, math.log(1e-3), math.log(1e-1)),
        's5_b_re': nrm(14, (N_EVEN, G_A, S5_STATE, S5_GROUP), S5_GROUP ** -0.5),
        's5_b_im': nrm(15, (N_EVEN, G_A, S5_STATE, S5_GROUP), S5_GROUP ** -0.5),
        's5_c_re': nrm(16, (N_EVEN, G_A, S5_GROUP, S5_STATE), (2 * S5_STATE) ** -0.5),
        's5_c_im': nrm(17, (N_EVEN, G_A, S5_GROUP, S5_STATE), (2 * S5_STATE) ** -0.5),
        's5_d': nrm(18, (N_EVEN, G_A, S5_GROUP), 1.0),
        's5_glu_w': nrm(19, (N_EVEN, D_A, D_A), D_A ** -0.5),
        's5_glu_b': nrm(20, (N_EVEN, D_A), 0.01),
        'sgu_norm': 1.0 + nrm(21, (N_EVEN, D_B), 0.02),
        'sgu_w': nrm(22, (N_EVEN, H_B, CHUNK, CHUNK), CHUNK ** -0.5),
        'sgu_b': 1.0 + nrm(23, (N_EVEN, H_B, CHUNK), 0.02),
        'w_in_odd': nrm(24, (N_ODD, D_MODEL, D_IN_ODD), D_MODEL ** -0.5),
        'w_out_odd': nrm(25, (N_ODD, D_C + D_D, D_MODEL), (D_C + D_D) ** -0.5),
        'pool_w': nrm(26, (N_ODD, N_POOL, C_GROUP, C_GROUP), C_GROUP ** -0.5),
        'pool_scale': 1.0 + nrm(27, (N_ODD, D_C), 0.02),
        'conv_w': nrm(28, (N_ODD, CONV_W, D_D), CONV_W ** -0.5),
        'conv_b': nrm(29, (N_ODD, D_D), 0.01),
        'ffn_w_gate': nrm(30, (DEPTH, D_MODEL, D_FF), D_MODEL ** -0.5),
        'ffn_w_up': nrm(31, (DEPTH, D_MODEL, D_FF), D_MODEL ** -0.5),
        'ffn_w_down': nrm(32, (DEPTH, D_FF, D_MODEL), D_FF ** -0.5),
    }


def reference(x_prompt, x_sample, state_s5_re, state_s5_im, state_pool, state_conv,
              norm_mix, norm_ffn, norm_final, w_in_even, w_out_even,
              s5_lambda_re, s5_lambda_im, s5_log_dt, s5_b_re, s5_b_im, s5_c_re, s5_c_im, s5_d,
              s5_glu_w, s5_glu_b, sgu_norm, sgu_w, sgu_b, w_in_odd, w_out_odd,
              pool_w, pool_scale, conv_w, conv_b, ffn_w_gate, ffn_w_up, ffn_w_down):
    W = dict(norm_mix=norm_mix, norm_ffn=norm_ffn, norm_final=norm_final,
             w_in_even=w_in_even, w_out_even=w_out_even,
             s5_lambda_re=s5_lambda_re, s5_lambda_im=s5_lambda_im, s5_log_dt=s5_log_dt,
             s5_b_re=s5_b_re, s5_b_im=s5_b_im, s5_c_re=s5_c_re, s5_c_im=s5_c_im, s5_d=s5_d,
             s5_glu_w=s5_glu_w, s5_glu_b=s5_glu_b, sgu_norm=sgu_norm, sgu_w=sgu_w, sgu_b=sgu_b,
             w_in_odd=w_in_odd, w_out_odd=w_out_odd, pool_w=pool_w, pool_scale=pool_scale,
             conv_w=conv_w, conv_b=conv_b, ffn_w_gate=ffn_w_gate, ffn_w_up=ffn_w_up, ffn_w_down=ffn_w_down)
    bp = x_prompt.shape[0]
    z_re = jnp.zeros((N_EVEN, bp, G_A, S5_STATE), state_s5_re.dtype)
    z_pool = jnp.zeros((N_ODD, bp, POOL_BUF, D_C), x_prompt.dtype)
    z_conv = jnp.zeros((N_ODD, bp, CONV_W - 1, D_D), x_prompt.dtype)
    y_prompt, p_s5_re, p_s5_im, _, p_pool, p_conv = run_trunk(x_prompt, z_re, z_re, z_pool, z_conv, 0.0, W)
    y_sample, s_s5_re, s_s5_im, s_sgu_v, s_pool, s_conv = run_trunk(
        x_sample, state_s5_re, state_s5_im, state_pool, state_conv, 1.0, W)
    return (y_prompt, y_sample, p_s5_re, p_s5_im, p_pool, p_conv, s_s5_re, s_s5_im, s_sgu_v, s_pool, s_conv)
```

```cpp
#include <hip/hip_runtime.h>
#include <hip/hip_cooperative_groups.h>
#include <cstdio>
#include <cstdint>
namespace cg = cooperative_groups;

#ifndef MK_PER_PHASE
#define MK_PER_PHASE 0
#endif

#ifndef DBG_LAYERS
#define DBG_LAYERS 4
#endif
#ifndef DBG_SKIP
#define DBG_SKIP 0
#endif
#define LAS __attribute__((address_space(3)))
typedef unsigned short bf16_t;
typedef short bf16x8 __attribute__((ext_vector_type(8)));
typedef float f32x2 __attribute__((ext_vector_type(2)));
typedef float f32x4 __attribute__((ext_vector_type(4)));
typedef float f32x16 __attribute__((ext_vector_type(16)));
typedef unsigned u32x4 __attribute__((ext_vector_type(4)));
typedef unsigned u32x2 __attribute__((ext_vector_type(2)));

constexpr int DM = 1024, MP = 16384, MSAMP = 512, MT = MP + MSAMP, FF = 2816, NGU = 2 * FF, SEQ = 2048;
constexpr float EPS = 1e-6f;
constexpr int PLD = 2048;
constexpr size_t O_Y = 0, O_PRE = 17301504, O_PIM = 17334272, O_PPOOL = 17367040, O_PCONV = 17489920, O_SRE = 17506304, O_SIM = 18030592,
                 O_SV = 18554880, O_SPOOL = 19079168, O_SCONV = 21045248, O_END = 21307392;
constexpr size_t MiB = 1u << 20;
constexpr size_t WS_SSQ = 226 * MiB, WS_SSQV = 237 * MiB;
constexpr size_t WS_ATAB = 1 * MiB, WS_A128 = WS_ATAB + 32768, WS_BBAR = WS_ATAB + 65536, WS_CTAB = WS_BBAR + 262144, WS_WM = WS_CTAB + 262144;
constexpr size_t WS_SLOC = 3 * MiB;
constexpr size_t WS_W1E = 5 * MiB, WS_WOE = 11 * MiB, WS_GLU = 15 * MiB, WS_W1O = 16 * MiB, WS_WOO = 24 * MiB, WS_WGU = 28 * MiB, WS_WD = 72 * MiB;
constexpr size_t WS_HB = 94 * MiB, WS_PROJ = 127 * MiB, WS_MIX = 193 * MiB, WS_ACT = 127 * MiB, WS_ACT_END = 226 * MiB, WS_CAR = 239 * MiB, WS_END = 241 * MiB;
static_assert(WS_WM + 524288 <= WS_SLOC && WS_SSQ + 9 * (size_t)MT * 64 <= WS_SSQV && WS_SSQV + 2 * (size_t)MT * 32 <= 239 * MiB, "ws map");
static_assert(WS_ACT + (size_t)MT * FF * 2 <= WS_ACT_END, "act overlay");

constexpr int LDS_BYTES = 147456;
constexpr int WREG = 17408;

typedef __bf16 bf16x2_t __attribute__((ext_vector_type(2)));
__device__ __forceinline__ unsigned cvt_pk_bf16(float lo, float hi) { const f32x2 v = {lo, hi}; const bf16x2_t b = __builtin_convertvector(v, bf16x2_t); return __builtin_bit_cast(unsigned, b); }
__device__ __forceinline__ float bf_lo(unsigned w) { return __uint_as_float(w << 16); }
__device__ __forceinline__ float bf_hi(unsigned w) { return __uint_as_float(w & 0xffff0000u); }
__device__ __forceinline__ float bf1(bf16_t b) { return __uint_as_float((unsigned)b << 16); }
__device__ __forceinline__ bf16_t f2bf(float f) { return (bf16_t)(cvt_pk_bf16(f, 0.f) & 0xffffu); }
__device__ __forceinline__ float rstd_of(float ssq, float invn) { return rsqrtf(ssq * invn + EPS); }
__device__ __forceinline__ float sigmoidf_(float x) { return __builtin_amdgcn_rcpf(1.0f + __expf(-x)); }
#define LDS_WAIT() asm volatile("s_waitcnt lgkmcnt(0)" ::: "memory")
__device__ __forceinline__ float row_ssq16(const float* part, int row, int fq) { const f32x4 p = *(const f32x4*)(part + ((size_t)fq * MT + row) * 4);     float s = (p[0] + p[1]) + (p[2] + p[3]); s += __shfl_xor(s, 16); s += __shfl_xor(s, 32); return s; }
__device__ __forceinline__ int launder_v(int x) { asm volatile("" : "+v"(x)); return x; }
__device__ __forceinline__ size_t launder_zero() { size_t z = 0; asm volatile("" : "+s"(z)); return z; }

namespace pg8 {
constexpr int BM = 256, BK = 64, HALF = 128, HTB = HALF * BK * 2, STAGE_BYTES = 8 * HTB, NXCD = 8, WGM = 8;
__host__ __device__ __forceinline__ int lds_byte(int r, int c) { const int st = (r >> 4) * 2 + (c >> 5), rr = r & 15, cc = c & 31, ob = rr * 64 + cc * 2; return st * 1024 + (ob ^ (((ob >> 9) & 1) << 5)); }
__host__ __device__ __forceinline__ void stage_rc(int b, int& R, int& C) { const int st = b / 1024, sb = b % 1024, swz = sb ^ (((sb >> 9) & 1) << 5); R = (st >> 1) * 16 + swz / 64; C = (st & 1) * 32 + (swz % 64) / 2; }
__host__ __device__ __forceinline__ int perm32(int rho) { const int n = rho >> 4, i = rho & 15; return 8 * (i >> 2) + 4 * n + (i & 3); }
struct Unit { int pm, pn; };
struct Gemm { const bf16_t* A; const bf16_t* Bt; int M, N, K, lda, ldb; };
struct StaticOrder {
    int nM, nN, nwg, G, c;
    __device__ void init(int M, int N, int G_, int c_) { nM = M / BM; nN = N / BM; nwg = nM * nN; G = G_; c = c_; }
    __device__ bool next(int i, Unit& u) const {
        const long L = (long)i * G + c; if (L >= nwg) return false;
        int wgid = (int)L; { const int q = nwg / NXCD, r = nwg % NXCD, xcd = wgid % NXCD, off = wgid / NXCD; wgid = (xcd < r ? xcd * (q + 1) : r * (q + 1) + (xcd - r) * q) + off; }
        const int nig = WGM * nN, gid = wgid / nig, fm = gid * WGM, gsz = (nM - fm) < WGM ? (nM - fm) : WGM;
        u.pm = fm + ((wgid % nig) % gsz); u.pn = (wgid % nig) / gsz; return true;
    }
};

struct EpiProj {
    bf16_t* O; int ldc; const float* ssq_in; float* ssq_v; int vcol0;
    __device__ __forceinline__ void operator()(const f32x4 (&acc)[2][2][4][2], const Unit& u, int wr, int wc, int fr, int fq) const {
        const int row0 = u.pm * BM + wr * 64 + fr, col0 = u.pn * BM + wc * 32 + 8 * fq;
        const bool dov = (ssq_v != nullptr) && (u.pn * BM >= vcol0);
#pragma unroll
        for (int ai = 0; ai < 2; ++ai)
#pragma unroll
            for (int m = 0; m < 4; ++m) {
                const int row = row0 + ai * HALF + m * 16;
#if defined(DBG_NORS)
                const float rs = 1.0f;
#else
                const float rs = rstd_of(row_ssq16(ssq_in, row, fq), 1.0f / DM);
#endif
                float sq = 0.f;
#pragma unroll
                for (int bj = 0; bj < 2; ++bj) { const f32x4 v0 = acc[ai][bj][m][0] * rs, v1 = acc[ai][bj][m][1] * rs;
                    u32x4 w; w.x = cvt_pk_bf16(v0[0], v0[1]); w.y = cvt_pk_bf16(v0[2], v0[3]); w.z = cvt_pk_bf16(v1[0], v1[1]); w.w = cvt_pk_bf16(v1[2], v1[3]);
                    *(u32x4*)(O + (size_t)row * ldc + col0 + bj * HALF) = w;
                    sq += (v0[0] * v0[0] + v0[1] * v0[1]) + (v0[2] * v0[2] + v0[3] * v0[3]) + (v1[0] * v1[0] + v1[1] * v1[1]) + (v1[2] * v1[2] + v1[3] * v1[3]); }
                if (dov) { sq += __shfl_xor(sq, 16); sq += __shfl_xor(sq, 32); if (fq == 0) ssq_v[((size_t)(u.pn - vcol0 / BM) * MT + row) * 4 + wc] = sq; }
            }
    }
};
struct EpiGlu {
    bf16_t* O; int ldc; const bf16_t* Z; int ldz; const float* bias;
    __device__ __forceinline__ void operator()(const f32x4 (&acc)[2][2][4][2], const Unit& u, int wr, int wc, int fr, int fq) const {
        const int row0 = u.pm * BM + wr * 64 + fr, col0 = u.pn * BM + wc * 32 + 8 * fq;
        f32x4 bv[2][2];
#pragma unroll
        for (int bj = 0; bj < 2; ++bj)
#pragma unroll
            for (int n = 0; n < 2; ++n) bv[bj][n] = *(const f32x4*)(bias + col0 + bj * HALF + 4 * n);
#pragma unroll
        for (int ai = 0; ai < 2; ++ai)
#pragma unroll
            for (int m = 0; m < 4; ++m) {
                const int row = row0 + ai * HALF + m * 16;
#pragma unroll
                for (int bj = 0; bj < 2; ++bj) { const u32x4 z = *(const u32x4*)(Z + (size_t)row * ldz + col0 + bj * HALF);
                    const f32x4 g0 = acc[ai][bj][m][0] + bv[bj][0], g1 = acc[ai][bj][m][1] + bv[bj][1];
                    u32x4 w;
                    w.x = cvt_pk_bf16(bf_lo(z.x) * sigmoidf_(g0[0]), bf_hi(z.x) * sigmoidf_(g0[1])); w.y = cvt_pk_bf16(bf_lo(z.y) * sigmoidf_(g0[2]), bf_hi(z.y) * sigmoidf_(g0[3]));
                    w.z = cvt_pk_bf16(bf_lo(z.z) * sigmoidf_(g1[0]), bf_hi(z.z) * sigmoidf_(g1[1])); w.w = cvt_pk_bf16(bf_lo(z.w) * sigmoidf_(g1[2]), bf_hi(z.w) * sigmoidf_(g1[3]));
                    *(u32x4*)(O + (size_t)row * ldc + col0 + bj * HALF) = w; }
            }
    }
};
struct EpiResid {
    float* H; bf16_t* HB; float* ssq_out;
    __device__ __forceinline__ void operator()(const f32x4 (&acc)[2][2][4][2], const Unit& u, int wr, int wc, int fr, int fq) const {
        const int row0 = u.pm * BM + wr * 64 + fr, col0 = u.pn * BM + wc * 32 + 8 * fq;
#pragma unroll
        for (int ai = 0; ai < 2; ++ai)
#pragma unroll
            for (int m = 0; m < 4; ++m) {
                const int row = row0 + ai * HALF + m * 16; float sq = 0.f;
#pragma unroll
                for (int bj = 0; bj < 2; ++bj) { float* hp = H + (size_t)row * DM + col0 + bj * HALF;
                    const f32x4 v0 = *(const f32x4*)hp + acc[ai][bj][m][0], v1 = *(const f32x4*)(hp + 4) + acc[ai][bj][m][1];
                    *(f32x4*)hp = v0; *(f32x4*)(hp + 4) = v1;
                    u32x4 w; w.x = cvt_pk_bf16(v0[0], v0[1]); w.y = cvt_pk_bf16(v0[2], v0[3]); w.z = cvt_pk_bf16(v1[0], v1[1]); w.w = cvt_pk_bf16(v1[2], v1[3]);
                    *(u32x4*)(HB + (size_t)row * DM + col0 + bj * HALF) = w;
                    sq += (v0[0] * v0[0] + v0[1] * v0[1]) + (v0[2] * v0[2] + v0[3] * v0[3]) + (v1[0] * v1[0] + v1[1] * v1[1]) + (v1[2] * v1[2] + v1[3] * v1[3]); }
                sq += __shfl_xor(sq, 16); sq += __shfl_xor(sq, 32); if (fq == 0) ssq_out[((size_t)u.pn * MT + row) * 4 + wc] = sq;
                if (m & 1) asm volatile("" ::: "memory");
            }
    }
};
struct EpiSwiglu {
    bf16_t* O; const float* ssq_in;
    __device__ __forceinline__ void operator()(const f32x4 (&acc)[2][2][4][2], const Unit& u, int wr, int wc, int fr, int fq) const {
        const int row0 = u.pm * BM + wr * 64 + fr, col0 = u.pn * HALF + wc * 32 + 8 * fq;
#pragma unroll
        for (int ai = 0; ai < 2; ++ai)
#pragma unroll
            for (int m = 0; m < 4; ++m) {
                const int row = row0 + ai * HALF + m * 16; const float rs = rstd_of(row_ssq16(ssq_in, row, fq), 1.0f / DM);
                const f32x4 g0 = acc[ai][0][m][0] * rs, g1 = acc[ai][0][m][1] * rs, u0 = acc[ai][1][m][0] * rs, u1 = acc[ai][1][m][1] * rs;
                u32x4 w;
                w.x = cvt_pk_bf16(g0[0] * sigmoidf_(g0[0]) * u0[0], g0[1] * sigmoidf_(g0[1]) * u0[1]); w.y = cvt_pk_bf16(g0[2] * sigmoidf_(g0[2]) * u0[2], g0[3] * sigmoidf_(g0[3]) * u0[3]);
                w.z = cvt_pk_bf16(g1[0] * sigmoidf_(g1[0]) * u1[0], g1[1] * sigmoidf_(g1[1]) * u1[1]); w.w = cvt_pk_bf16(g1[2] * sigmoidf_(g1[2]) * u1[2], g1[3] * sigmoidf_(g1[3]) * u1[3]);
                *(u32x4*)(O + (size_t)row * FF + col0) = w;
            }
    }
};

struct OneUnit { Unit u; __device__ bool next(int i, Unit& o) const { if (i != 0) return false; o = u; return true; } };
template <class Epi, bool ALIGN_EPI = true, class Sched = StaticOrder>
__device__ __forceinline__ void gemm_phase(LAS unsigned char* lds, const Gemm g, const Sched& S, const Epi& E) {
    const int tid = launder_v(threadIdx.x), wid = __builtin_amdgcn_readfirstlane(tid >> 6), lane = tid & 63, wr = wid >> 2, wc = wid & 3, fr = lane & 15, fq = lane >> 4;
    const int K = g.K, nt = K / BK;
    unsigned voffA[2], voffB[2];
#pragma unroll
    for (int i = 0; i < 2; ++i) { int R, C; stage_rc(tid * 16 + i * 8192, R, C); const int Rb = (R & ~31) + perm32(R & 31);
        voffA[i] = (unsigned)(R * g.lda + C) * 2u; voffB[i] = (unsigned)(Rb * g.ldb + C) * 2u; }
    const size_t kstep = (size_t)(BK * 2);
    const size_t hstepA = (size_t)HALF * g.lda * 2, hstepB = (size_t)HALF * g.ldb * 2;
    const size_t tstepA = 2 * hstepA, tstepB = 2 * hstepB;
    const unsigned ldsw = (unsigned)wid * 1024u;
    const int aoff = lds_byte(wr * 64 + fr, fq * 8), boff = lds_byte(wc * 32 + fr, fq * 8);
#define PG8_SA(b, h) (((b) * 2 + (h)) * HTB)
#define PG8_SB(b, h) ((4 + (b) * 2 + (h)) * HTB)
#define PG8_STAGE(bufoff, gbase, voff) do { _Pragma("unroll") for (int _i = 0; _i < 2; ++_i) \
        __builtin_amdgcn_global_load_lds((const unsigned*)((const char*)(gbase) + (voff)[_i]), (LAS unsigned*)(lds + (bufoff) + ldsw + _i * 8192), 16, 0, 0); } while (0)
#define PG8_LDA(dst, b, h) do { _Pragma("unroll") for (int m = 0; m < 4; ++m) _Pragma("unroll") for (int k = 0; k < 2; ++k) dst[m][k] = *(const LAS bf16x8*)(lds + PG8_SA(b, h) + aoff + m * 2048 + k * 1024); } while (0)
#define PG8_LDB(dst, b, h) do { _Pragma("unroll") for (int n = 0; n < 2; ++n) _Pragma("unroll") for (int k = 0; k < 2; ++k) dst[n][k] = *(const LAS bf16x8*)(lds + PG8_SB(b, h) + boff + n * 2048 + k * 1024); } while (0)
#define PG8_MMA(ai, bj, At, Bt) do { __builtin_amdgcn_s_setprio(1); _Pragma("unroll") for (int m = 0; m < 4; ++m) _Pragma("unroll") for (int n = 0; n < 2; ++n) _Pragma("unroll") for (int k = 0; k < 2; ++k) \
        acc[ai][bj][m][n] = __builtin_amdgcn_mfma_f32_16x16x32_bf16(Bt[n][k], At[m][k], acc[ai][bj][m][n], 0, 0, 0); __builtin_amdgcn_s_setprio(0); } while (0)
#define PG8_WAIT_V(n) asm volatile("s_waitcnt vmcnt(" #n ")" ::: "memory")
#define PG8_WAIT_L(n) asm volatile("s_waitcnt lgkmcnt(" #n ")" ::: "memory")
#define PG8_BAR __builtin_amdgcn_s_barrier()
#define PG8_SCHED __builtin_amdgcn_sched_barrier(0)
    Unit cur, nxt; int ui = 0;
    if (!S.next(0, cur)) return;
    f32x4 acc[2][2][4][2];
#pragma unroll
    for (int a = 0; a < 2; ++a)
#pragma unroll
        for (int b = 0; b < 2; ++b)
#pragma unroll
            for (int m = 0; m < 4; ++m)
#pragma unroll
                for (int n = 0; n < 2; ++n) acc[a][b][m][n] = (f32x4){0.f, 0.f, 0.f, 0.f};
    bf16x8 At[4][2], B0[2][2], B1[2][2];
    const char* cA = (const char*)g.A + (size_t)cur.pm * tstepA; const char* cB = (const char*)g.Bt + (size_t)cur.pn * tstepB;
    PG8_STAGE(PG8_SB(0, 0), cB, voffB); PG8_STAGE(PG8_SB(0, 1), cB + hstepB, voffB); PG8_STAGE(PG8_SA(0, 0), cA, voffA); PG8_STAGE(PG8_SA(0, 1), cA + hstepA, voffA);
    if (wr == 1) PG8_BAR;
    PG8_WAIT_V(2); PG8_BAR;
    PG8_STAGE(PG8_SB(1, 0), cB + kstep, voffB); PG8_STAGE(PG8_SA(1, 0), cA + kstep, voffA); PG8_STAGE(PG8_SB(1, 1), cB + hstepB + kstep, voffB);
    PG8_WAIT_V(6); PG8_BAR;
    for (;;) {
        const bool has_next = S.next(ui + 1, nxt);
        const char* nA = has_next ? (const char*)g.A + (size_t)nxt.pm * tstepA : cA; const char* nB = has_next ? (const char*)g.Bt + (size_t)nxt.pn * tstepB : cB;
        for (int t = 0; t < nt; t += 2) {
            const bool last = (t == nt - 2);
            const char* a1 = cA + (size_t)(t + 1) * kstep;
            const char* a2 = last ? nA : cA + (size_t)(t + 2) * kstep; const char* b2 = last ? nB : cB + (size_t)(t + 2) * kstep;
            const char* a3 = a2 + kstep; const char* b3 = b2 + kstep;
            PG8_LDB(B0, 0, 0); PG8_LDB(B1, 0, 1); PG8_SCHED; PG8_LDA(At, 0, 0); PG8_STAGE(PG8_SA(1, 1), a1 + hstepA, voffA);
            PG8_WAIT_V(8); PG8_WAIT_L(0); PG8_BAR; PG8_MMA(0, 0, At, B0); PG8_MMA(0, 1, At, B1); PG8_BAR; PG8_SCHED;
            PG8_LDA(At, 0, 1); PG8_STAGE(PG8_SB(0, 0), b2, voffB); PG8_STAGE(PG8_SB(0, 1), b2 + hstepB, voffB); PG8_STAGE(PG8_SA(0, 0), a2, voffA);
            PG8_WAIT_V(8); PG8_WAIT_L(0); PG8_BAR; PG8_MMA(1, 0, At, B0); PG8_MMA(1, 1, At, B1); PG8_BAR; PG8_SCHED;
            PG8_LDB(B0, 1, 0); PG8_LDB(B1, 1, 1); PG8_SCHED; PG8_LDA(At, 1, 0); PG8_STAGE(PG8_SA(0, 1), a2 + hstepA, voffA);
            PG8_WAIT_V(8); PG8_WAIT_L(0); PG8_BAR; PG8_MMA(0, 0, At, B0); PG8_MMA(0, 1, At, B1); PG8_BAR; PG8_SCHED;
            PG8_LDA(At, 1, 1); PG8_STAGE(PG8_SB(1, 0), b3, voffB); PG8_STAGE(PG8_SB(1, 1), b3 + hstepB, voffB); PG8_STAGE(PG8_SA(1, 0), a3, voffA);
            PG8_WAIT_V(8); PG8_WAIT_L(0); PG8_BAR; PG8_MMA(1, 0, At, B0); PG8_MMA(1, 1, At, B1); PG8_BAR; PG8_SCHED;
        }
        if constexpr (ALIGN_EPI) { if (wr == 0) PG8_BAR; }
        E(acc, cur, wr, wc, fr, fq);
        if (!has_next) break;
#pragma unroll
        for (int a = 0; a < 2; ++a)
#pragma unroll
            for (int b = 0; b < 2; ++b)
#pragma unroll
                for (int m = 0; m < 4; ++m)
#pragma unroll
                    for (int n = 0; n < 2; ++n) acc[a][b][m][n] = (f32x4){0.f, 0.f, 0.f, 0.f};
        cur = nxt; cA = nA; cB = nB; ++ui;
        if constexpr (ALIGN_EPI) { if (wr == 1) PG8_BAR; }
    }
    PG8_WAIT_V(0);
    if constexpr (!ALIGN_EPI) { if (wr == 0) PG8_BAR; }
    PG8_BAR;
#undef PG8_SA
#undef PG8_SB
#undef PG8_STAGE
#undef PG8_LDA
#undef PG8_LDB
#undef PG8_MMA
#undef PG8_WAIT_V
#undef PG8_WAIT_L
#undef PG8_BAR
#undef PG8_SCHED
}

template <class Epi>
__device__ __forceinline__ void gemm_unit_rs(LAS unsigned char* lds, const Gemm g, const Unit cur, const Epi& E) {
    const int tid = launder_v(threadIdx.x), wid = __builtin_amdgcn_readfirstlane(tid >> 6), lane = tid & 63, wr = wid >> 2, wc = wid & 3, fr = lane & 15, fq = lane >> 4;
    const int nt = g.K / BK;
    unsigned voffA[2], voffB[2];
#pragma unroll
    for (int i = 0; i < 2; ++i) { int R, C; stage_rc(tid * 16 + i * 8192, R, C); const int Rb = (R & ~31) + perm32(R & 31);
        voffA[i] = (unsigned)(R * g.lda + C) * 2u; voffB[i] = (unsigned)(Rb * g.ldb + C) * 2u; }
    const size_t hstepA = (size_t)HALF * g.lda * 2, hstepB = (size_t)HALF * g.ldb * 2;
    const char* cA = (const char*)g.A + (size_t)cur.pm * 2 * hstepA; const char* cB = (const char*)g.Bt + (size_t)cur.pn * 2 * hstepB;
    const int aoff = lds_byte(wr * 64 + fr, fq * 8), boff = lds_byte(wc * 32 + fr, fq * 8);
    const unsigned wofs = (unsigned)tid * 16u;
    f32x4 acc[2][2][4][2];
#pragma unroll
    for (int a = 0; a < 2; ++a)
#pragma unroll
        for (int b = 0; b < 2; ++b)
#pragma unroll
            for (int m = 0; m < 4; ++m)
#pragma unroll
                for (int n = 0; n < 2; ++n) acc[a][b][m][n] = (f32x4){0.f, 0.f, 0.f, 0.f};
    u32x4 st[8];
#define RS_LOAD(kt) do { const char* a_ = cA + (size_t)(kt) * (BK * 2); const char* b_ = cB + (size_t)(kt) * (BK * 2); \
        _Pragma("unroll") for (int h = 0; h < 2; ++h) _Pragma("unroll") for (int i = 0; i < 2; ++i) { \
            st[h * 2 + i] = *(const u32x4*)(a_ + h * hstepA + voffA[i]); st[4 + h * 2 + i] = *(const u32x4*)(b_ + h * hstepB + voffB[i]); } } while (0)
#define RS_STORE(buf) do { _Pragma("unroll") for (int h = 0; h < 2; ++h) _Pragma("unroll") for (int i = 0; i < 2; ++i) { \
            *(LAS u32x4*)(lds + ((buf) * 2 + h) * HTB + i * 8192 + wofs) = st[h * 2 + i]; *(LAS u32x4*)(lds + (4 + (buf) * 2 + h) * HTB + i * 8192 + wofs) = st[4 + h * 2 + i]; } } while (0)
    RS_LOAD(0); RS_STORE(0); __syncthreads();
    for (int kt = 0; kt < nt; ++kt) {
        const int b = kt & 1;
        if (kt + 1 < nt) RS_LOAD(kt + 1);
        __builtin_amdgcn_sched_barrier(0);
        bf16x8 B0[2][2], B1[2][2], At[4][2];
#pragma unroll
        for (int n = 0; n < 2; ++n)
#pragma unroll
            for (int k = 0; k < 2; ++k) { B0[n][k] = *(const LAS bf16x8*)(lds + (4 + b * 2 + 0) * HTB + boff + n * 2048 + k * 1024); B1[n][k] = *(const LAS bf16x8*)(lds + (4 + b * 2 + 1) * HTB + boff + n * 2048 + k * 1024); }
#pragma unroll
        for (int ai = 0; ai < 2; ++ai) {
#pragma unroll
            for (int m = 0; m < 4; ++m)
#pragma unroll
                for (int k = 0; k < 2; ++k) At[m][k] = *(const LAS bf16x8*)(lds + (b * 2 + ai) * HTB + aoff + m * 2048 + k * 1024);
#pragma unroll
            for (int m = 0; m < 4; ++m)
#pragma unroll
                for (int n = 0; n < 2; ++n)
#pragma unroll
                    for (int k = 0; k < 2; ++k) { acc[ai][0][m][n] = __builtin_amdgcn_mfma_f32_16x16x32_bf16(B0[n][k], At[m][k], acc[ai][0][m][n], 0, 0, 0);
                                                  acc[ai][1][m][n] = __builtin_amdgcn_mfma_f32_16x16x32_bf16(B1[n][k], At[m][k], acc[ai][1][m][n], 0, 0, 0); }
        }
        __builtin_amdgcn_sched_barrier(0);
        if (kt + 1 < nt) RS_STORE(b ^ 1);
        __syncthreads();
    }
#undef RS_LOAD
#undef RS_STORE
    E(acc, cur, wr, wc, fr, fq);
}
}

__device__ __forceinline__ float wave_sum(float v) {
#pragma unroll
    for (int o = 1; o < 64; o <<= 1) v += __shfl_xor(v, o);
    return v;
}
__device__ __forceinline__ void xpose_mat(const float* __restrict__ W, int ldw, int K, int N, bf16_t* dst, int ldt, int dcol0, const float* __restrict__ gain, int mapmode,
                                          LAS float* scr, int gw, int NGW, int lane) {
    const int nblk = N / 32, nit = (K / 64) * nblk;
    for (int it = gw; it < nit; it += NGW) {
        const int kb = it / nblk, nb = it % nblk, k0 = 64 * kb, n0 = 32 * nb;
#pragma unroll 8
        for (int i = 0; i < 32; ++i) { const int kk = 2 * i + (lane >> 5); float w = W[(size_t)(k0 + kk) * ldw + n0 + (lane & 31)]; if (gain) w *= gain[k0 + kk]; scr[kk * 33 + (lane & 31)] = w; }
        LDS_WAIT();
        const int c = lane & 7;
#pragma unroll
        for (int j = 0; j < 4; ++j) { const int n = (lane >> 3) + 8 * j; const LAS float* s = scr + (8 * c) * 33 + n;
            u32x4 o; o.x = cvt_pk_bf16(s[0 * 33], s[1 * 33]); o.y = cvt_pk_bf16(s[2 * 33], s[3 * 33]); o.z = cvt_pk_bf16(s[4 * 33], s[5 * 33]); o.w = cvt_pk_bf16(s[6 * 33], s[7 * 33]);
            const int nn = n0 + n; const int row = mapmode == 0 ? nn : (256 * (nn >> 7) + (nn & 127) + (mapmode == 2 ? 128 : 0));
            *(u32x4*)(dst + (size_t)row * ldt + dcol0 + k0 + 8 * c) = o; }
        LDS_WAIT();
    }
}
__device__ __forceinline__ void sincos_d(double x, double& s, double& c) {
    const double q = __builtin_rint(x * 0.63661977236758134308), r = (x - q * 1.57079632679489655800) - q * 6.12323399573676603587e-17;
    const double r2 = r * r;
    double sp = r * (1.0 + r2 * (-1.0 / 6 + r2 * (1.0 / 120 + r2 * (-1.0 / 5040 + r2 * (1.0 / 362880 + r2 * (-1.0 / 39916800 + r2 * (1.0 / 6227020800.0)))))));
    double cp = 1.0 + r2 * (-0.5 + r2 * (1.0 / 24 + r2 * (-1.0 / 720 + r2 * (1.0 / 40320 + r2 * (-1.0 / 3628800 + r2 * (1.0 / 479001600 + r2 * (-1.0 / 87178291200.0)))))));
    const int qi = ((int)q) & 3;
    s = (qi == 0) ? sp : (qi == 1) ? cp : (qi == 2) ? -sp : -cp;
    c = (qi == 0) ? cp : (qi == 1) ? -sp : (qi == 2) ? -cp : sp;
}

struct Args { const float* in[33]; float* out; unsigned char* ws; int ph_lo, ph_hi; };

struct S5Ctx { const bf16_t* PROJ; bf16_t* PROJw; const f32x2* Atab; const f32x2* A128; const bf16_t* Bbar; const bf16_t* Ctab; const float* Dsk; f32x2* Sloc; const f32x2* Car;
               const float* st_re; const float* st_im; float* p_re; float* p_im; float* s_re; float* s_im; };

template <bool PASSB>
__device__ __forceinline__ void s5_unit(const S5Ctx& S, LAS float* X, int lane, int m0, int g, bool sample, int b, int c) {
    const int l31 = lane & 31, lh = lane >> 5, l15 = lane & 15, lq = lane >> 4;
    bf16x8 Bf[4];
#pragma unroll
    for (int sb = 0; sb < 4; ++sb) Bf[sb] = *(const bf16x8*)(S.Bbar + ((g * 128 + 32 * sb + l31) * 16 + 8 * lh));
    const f32x2 a = {((const float*)S.Atab)[g * 64 + lane], ((const float*)S.Atab)[4096 + g * 64 + lane]};
    bf16x8 Cf[4]; f32x4 Dv = (f32x4){0.f, 0.f, 0.f, 0.f};
    if (PASSB) {
#pragma unroll
        for (int ks = 0; ks < 4; ++ks) Cf[ks] = *(const bf16x8*)(S.Ctab + ((g * 16 + l15) * 128 + 32 * ks + 8 * lq));
        Dv = *(const f32x4*)(S.Dsk + g * 16 + 4 * lq);
    }
    float hr = 0.f, hi = 0.f;
    if (PASSB && !sample && c > 0) { const float* cp = (const float*)S.Car + (size_t)((b * 16 + c) * 32 + g) * 64 + lane; hr = cp[0]; hi = cp[262144]; }
    for (int tb = 0; tb < 4; ++tb) {
        const bf16x8 Af = *(const bf16x8*)(S.PROJ + (size_t)(m0 + 32 * tb + l31) * PLD + g * 16 + 8 * lh);
#pragma unroll
        for (int sb = 0; sb < 4; ++sb) {
            f32x16 acc;
#pragma unroll
            for (int r = 0; r < 16; ++r) acc[r] = 0.f;
            acc = __builtin_amdgcn_mfma_f32_32x32x16_bf16(Af, Bf[sb], acc, 0, 0, 0);
#pragma unroll
            for (int r = 0; r < 16; ++r) X[(8 * (r >> 2) + 4 * lh + (r & 3)) * 132 + 32 * sb + l31] = acc[r];
        }
        LDS_WAIT();
#pragma unroll 8
        for (int t = 0; t < 32; ++t) {
            if (sample && (t & 3) == 0) { const int bi = b + ((32 * tb + t) >> 2); hr = S.st_re[(size_t)(bi * 32 + g) * 64 + lane]; hi = S.st_im[(size_t)(bi * 32 + g) * 64 + lane]; }
            const float xr = X[t * 132 + lane], xi = X[t * 132 + 64 + lane];
            const float nr = a.x * hr - a.y * hi + xr, ni = a.x * hi + a.y * hr + xi; hr = nr; hi = ni;
            if (PASSB) { X[t * 132 + lane] = hr; X[t * 132 + 64 + lane] = hi; }
            if (PASSB && sample && (t & 3) == 3) { const int bi = b + ((32 * tb + t) >> 2); S.s_re[(size_t)(bi * 32 + g) * 64 + lane] = hr; S.s_im[(size_t)(bi * 32 + g) * 64 + lane] = hi; }
        }
        LDS_WAIT();
        if (PASSB) {
#pragma unroll
            for (int tb2 = 0; tb2 < 2; ++tb2) {
                f32x4 acc = (f32x4){0.f, 0.f, 0.f, 0.f};
#pragma unroll
                for (int ks = 0; ks < 4; ++ks) { const LAS float* hp = X + (16 * tb2 + l15) * 132 + 32 * ks + 8 * lq;
                    const f32x4 h0 = *(const LAS f32x4*)hp, h1 = *(const LAS f32x4*)(hp + 4);
                    u32x4 hw; hw.x = cvt_pk_bf16(h0[0], h0[1]); hw.y = cvt_pk_bf16(h0[2], h0[3]); hw.z = cvt_pk_bf16(h1[0], h1[1]); hw.w = cvt_pk_bf16(h1[2], h1[3]);
                    acc = __builtin_amdgcn_mfma_f32_16x16x32_bf16(Cf[ks], __builtin_bit_cast(bf16x8, hw), acc, 0, 0, 0); }
                const size_t m = (size_t)(m0 + 32 * tb + 16 * tb2 + l15);
                const u32x2 uu = *(const u32x2*)(S.PROJ + m * PLD + g * 16 + 4 * lq);
                float y[4]; y[0] = acc[0] + Dv[0] * bf_lo(uu.x); y[1] = acc[1] + Dv[1] * bf_hi(uu.x); y[2] = acc[2] + Dv[2] * bf_lo(uu.y); y[3] = acc[3] + Dv[3] * bf_hi(uu.y);
#pragma unroll
                for (int r = 0; r < 4; ++r) y[r] = y[r] * sigmoidf_(1.5957691216057308f * (y[r] + 0.044715f * y[r] * y[r] * y[r]));
                u32x2 zw; zw.x = cvt_pk_bf16(y[0], y[1]); zw.y = cvt_pk_bf16(y[2], y[3]);
                *(u32x2*)(S.PROJw + m * PLD + 1536 + g * 16 + 4 * lq) = zw;
            }
            LDS_WAIT();
        }
    }
    if (!PASSB) { float* sp = (float*)S.Sloc + (size_t)((b * 16 + c) * 32 + g) * 64 + lane; sp[0] = hr; sp[262144] = hi; }
    if (PASSB && !sample && c == 15) { S.p_re[(size_t)(b * 32 + g) * 64 + lane] = hr; S.p_im[(size_t)(b * 32 + g) * 64 + lane] = hi; }
}

struct SguCtx { const bf16_t* PROJ; bf16_t* MIX; const float* ssqv; const float* gnorm; const bf16_t* Wm; const float* sgu_w; const float* sgu_b; float* s_v; };

__device__ __forceinline__ void sgu_unit(const SguCtx& S, LAS bf16_t* VT, int lane, int m0, int hd) {
    const int l15 = lane & 15, lq = lane >> 4;
#pragma unroll
    for (int jj = 0; jj < 2; ++jj) {
        const int j = lane + 64 * jj; const size_t m = (size_t)(m0 + j); const f32x4 q0 = *(const f32x4*)(S.ssqv + m * 4), q1 = *(const f32x4*)(S.ssqv + ((size_t)MT + m) * 4); const float rs = rstd_of(((q0[0] + q0[1]) + (q0[2] + q0[3])) + ((q1[0] + q1[1]) + (q1[2] + q1[3])), 1.0f / 512);
#pragma unroll
        for (int d8 = 0; d8 < 8; ++d8) {
            const u32x4 v = *(const u32x4*)(S.PROJ + m * PLD + 1024 + hd * 64 + 8 * d8);
            const f32x4 g0 = *(const f32x4*)(S.gnorm + hd * 64 + 8 * d8), g1 = *(const f32x4*)(S.gnorm + hd * 64 + 8 * d8 + 4);
            LAS bf16_t* p = VT + (8 * d8) * 136 + j;
            p[0 * 136] = f2bf(bf_lo(v.x) * rs * g0[0]); p[1 * 136] = f2bf(bf_hi(v.x) * rs * g0[1]); p[2 * 136] = f2bf(bf_lo(v.y) * rs * g0[2]); p[3 * 136] = f2bf(bf_hi(v.y) * rs * g0[3]);
            p[4 * 136] = f2bf(bf_lo(v.z) * rs * g1[0]); p[5 * 136] = f2bf(bf_hi(v.z) * rs * g1[1]); p[6 * 136] = f2bf(bf_lo(v.w) * rs * g1[2]); p[7 * 136] = f2bf(bf_hi(v.w) * rs * g1[3]);
        }
    }
    LDS_WAIT();
    for (int ib = 0; ib < 8; ++ib) {
        const int nks = (ib >> 1) + 1;
        bf16x8 Bw[4];
#pragma unroll
        for (int ks = 0; ks < 4; ++ks) if (ks < nks) Bw[ks] = *(const bf16x8*)(S.Wm + (size_t)((hd * 128 + 16 * ib + l15) * 128 + 32 * ks + 8 * lq));
        const int i = 16 * ib + l15; const size_t m = (size_t)(m0 + i); const float bias = S.sgu_b[hd * 128 + i];
#pragma unroll
        for (int db = 0; db < 4; ++db) {
            f32x4 acc = (f32x4){0.f, 0.f, 0.f, 0.f};
#pragma unroll
            for (int ks = 0; ks < 4; ++ks) if (ks < nks) {
                const bf16x8 Av = *(const LAS bf16x8*)(VT + (16 * db + l15) * 136 + 32 * ks + 8 * lq);
                acc = __builtin_amdgcn_mfma_f32_16x16x32_bf16(Av, Bw[ks], acc, 0, 0, 0);
            }
            const int col = hd * 64 + 16 * db + 4 * lq;
            const u32x2 uu = *(const u32x2*)(S.PROJ + m * PLD + 512 + col);
            u32x2 w; w.x = cvt_pk_bf16(bf_lo(uu.x) * (acc[0] + bias), bf_hi(uu.x) * (acc[1] + bias)); w.y = cvt_pk_bf16(bf_lo(uu.y) * (acc[2] + bias), bf_hi(uu.y) * (acc[3] + bias));
            *(u32x2*)(S.MIX + m * DM + 512 + col) = w;
        }
    }
    LDS_WAIT();
}

#define MAKE_SC S5Ctx SC{PROJ, PROJ, (const f32x2*)((const float*)(ws + WS_ATAB) + i * 2048), (const f32x2*)((const float*)(ws + WS_A128) + i * 2048), (const bf16_t*)(ws + WS_BBAR) + (size_t)i * 32 * 128 * 16, (const bf16_t*)(ws + WS_CTAB) + (size_t)i * 32 * 16 * 128, args.in[18] + i * 512, (f32x2*)(ws + WS_SLOC), (const f32x2*)(ws + WS_CAR), args.in[2] + (size_t)i * 128 * 2048, args.in[3] + (size_t)i * 128 * 2048, args.out + O_PRE + (size_t)i * 8 * 2048, args.out + O_PIM + (size_t)i * 8 * 2048, args.out + O_SRE + (size_t)i * 128 * 2048, args.out + O_SIM + (size_t)i * 128 * 2048};
#define MAKE_GC SguCtx GC{PROJ, MIX, ssqv + (size_t)i * MT * 8, args.in[21] + i * 512, (const bf16_t*)(ws + WS_WM) + (size_t)i * 8 * 128 * 128, args.in[22] + (size_t)i * 8 * 128 * 128, args.in[23] + i * 1024, args.out + O_SV + (size_t)i * 128 * 4 * 512};
#define RUN_GEMM(EPI) do { pg8::Unit uu_; for (int ui_ = 0; S.next(ui_, uu_); ++ui_) { pg8::gemm_unit_rs<EPI>(lds, g, uu_, E); } } while (0)
__global__ void __launch_bounds__(512, 2) fwd_megakernel(Args args) {
    extern __shared__ __attribute__((aligned(16))) unsigned char lds_raw[];
    LAS unsigned char* lds = (LAS unsigned char*)lds_raw;
    cg::grid_group grid = cg::this_grid();
    const int G = gridDim.x, bx = blockIdx.x, NGW = G * 8, NGT = G * 512;
    const int lo = args.ph_lo, hi = args.ph_hi; int pidx = 0;
#define PH_BEGIN if (pidx >= lo && pidx < hi) { \
    const int tid = launder_v(threadIdx.x), lane = tid & 63, wave = __builtin_amdgcn_readfirstlane(tid >> 6); \
    const int gw = bx * 8 + wave, gt = bx * 512 + tid; (void)gw; (void)gt; (void)lane; \
    const size_t lz_ = launder_zero(); unsigned char* ws = args.ws + lz_; float* H = args.out + lz_; \
    float* ssq = (float*)(ws + WS_SSQ); float* ssqv = (float*)(ws + WS_SSQV); (void)ssqv; bf16_t* HB = (bf16_t*)(ws + WS_HB); bf16_t* PROJ = (bf16_t*)(ws + WS_PROJ); bf16_t* MIX = (bf16_t*)(ws + WS_MIX); bf16_t* ACT = (bf16_t*)(ws + WS_ACT); \
    (void)ssq; (void)HB; (void)PROJ; (void)MIX; (void)ACT; (void)H; \
    LAS unsigned char* wreg = lds + wave * WREG; (void)wreg;
#define PH_END } if (pidx >= lo && pidx + 1 < hi) { asm volatile("s_waitcnt vmcnt(0) lgkmcnt(0)" ::: "memory"); __builtin_amdgcn_fence(__ATOMIC_RELEASE, "agent"); asm volatile("s_waitcnt vmcnt(0)" ::: "memory"); \
    grid.sync(); __builtin_amdgcn_fence(__ATOMIC_ACQUIRE, "agent"); asm volatile("s_waitcnt vmcnt(0)" ::: "memory"); } ++pidx;

    PH_BEGIN
    {
        LAS float* scr = (LAS float*)wreg;
        for (int i = 0; i < 2; ++i) {
            const int Le = 2 * i, Lo = 2 * i + 1;
            xpose_mat(args.in[9] + (size_t)i * DM * 1536, 1536, DM, 1536, (bf16_t*)(ws + WS_W1E + i * 3 * MiB), DM, 0, args.in[6] + Le * DM, 0, scr, gw, NGW, lane);
            xpose_mat(args.in[10] + (size_t)i * DM * DM, DM, DM, DM, (bf16_t*)(ws + WS_WOE + i * 2 * MiB), DM, 0, nullptr, 0, scr, gw, NGW, lane);
            xpose_mat(args.in[19] + (size_t)i * 512 * 512, 512, 512, 512, (bf16_t*)(ws + WS_GLU + i * (MiB / 2)), 512, 0, nullptr, 0, scr, gw, NGW, lane);
            xpose_mat(args.in[24] + (size_t)i * DM * 2048, 2048, DM, 2048, (bf16_t*)(ws + WS_W1O + i * 4 * MiB), DM, 0, args.in[6] + Lo * DM, 0, scr, gw, NGW, lane);
            xpose_mat(args.in[25] + (size_t)i * DM * DM + (size_t)512 * DM, DM, 512, DM, (bf16_t*)(ws + WS_WOO + i * 2 * MiB), DM, 512, nullptr, 0, scr, gw, NGW, lane);
        }
        for (int L = 0; L < 4; ++L) {
            bf16_t* wgu = (bf16_t*)(ws + WS_WGU + L * 11 * MiB);
            xpose_mat(args.in[30] + (size_t)L * DM * FF, FF, DM, FF, wgu, DM, 0, args.in[7] + L * DM, 1, scr, gw, NGW, lane);
            xpose_mat(args.in[31] + (size_t)L * DM * FF, FF, DM, FF, wgu, DM, 0, args.in[7] + L * DM, 2, scr, gw, NGW, lane);
            xpose_mat(args.in[32] + (size_t)L * FF * DM, DM, FF, DM, (bf16_t*)(ws + WS_WD + L * (11 * MiB / 2)), FF, 0, nullptr, 0, scr, gw, NGW, lane);
        }
        for (int it = gw; it < 2 * 4 * 2 * 128; it += NGW) {
            const int i = it >> 10, g = (it >> 8) & 3, ch = (it >> 7) & 1, n0 = (it & 127) * 8, c = ch * 64 + lane;
            const float* pw = args.in[26] + (size_t)((i * 4 + g) * 128 + c) * 128; const float* sc = args.in[27] + i * 512 + g * 128;
            const float* wo = args.in[25] + (size_t)i * DM * DM + (size_t)(g * 128) * DM + n0;
            float s8[8];
#pragma unroll
            for (int e = 0; e < 8; ++e) s8[e] = 0.f;
            for (int d = 0; d < 128; d += 4) {
                const f32x4 p4 = *(const f32x4*)(pw + d);
#pragma unroll
                for (int dd = 0; dd < 4; ++dd) { const float ps = p4[dd] * sc[d + dd]; const f32x4 w0 = *(const f32x4*)(wo + (size_t)(d + dd) * DM), w1 = *(const f32x4*)(wo + (size_t)(d + dd) * DM + 4);
                    s8[0] += ps * w0[0]; s8[1] += ps * w0[1]; s8[2] += ps * w0[2]; s8[3] += ps * w0[3]; s8[4] += ps * w1[0]; s8[5] += ps * w1[1]; s8[6] += ps * w1[2]; s8[7] += ps * w1[3]; }
            }
            bf16_t* dst = (bf16_t*)(ws + WS_WOO + i * 2 * MiB) + (size_t)n0 * DM + g * 128 + c;
#pragma unroll
            for (int e = 0; e < 8; ++e) dst[(size_t)e * DM] = f2bf(s8[e]);
        }
        for (int it = gt; it < 2 * 32 * 64; it += NGT) {
            const int i = it >> 11, g = (it >> 6) & 31, n = it & 63;
            const float lr = args.in[11][it], li = args.in[12][it], dt = expf(args.in[13][i * 32 + g]);
            const double mag = (double)expf(lr * dt); double sn, cs; sincos_d((double)li * (double)dt, sn, cs);
            const double ar = mag * cs, ai = mag * sn, den = (double)lr * lr + (double)li * li;
            const float fr = (float)(((ar - 1.0) * lr + ai * li) / den), fi = (float)((ai * lr - (ar - 1.0) * li) / den);
            ((float*)(ws + WS_ATAB))[it] = (float)ar; ((float*)(ws + WS_ATAB))[4096 + it] = (float)ai;
            double pr = ar, pi = ai;
#pragma unroll
            for (int s = 0; s < 7; ++s) { const double t = pr * pr - pi * pi; pi = 2.0 * pr * pi; pr = t; }
            ((float*)(ws + WS_A128))[it] = (float)pr; ((float*)(ws + WS_A128))[4096 + it] = (float)pi;
            bf16_t* bb = (bf16_t*)(ws + WS_BBAR); bf16_t* ct = (bf16_t*)(ws + WS_CTAB);
#pragma unroll 4
            for (int p = 0; p < 16; ++p) {
                const float br = args.in[14][(size_t)it * 16 + p], bi = args.in[15][(size_t)it * 16 + p];
                bb[(size_t)((i * 32 + g) * 128 + n) * 16 + p] = f2bf(fr * br - fi * bi); bb[(size_t)((i * 32 + g) * 128 + 64 + n) * 16 + p] = f2bf(fr * bi + fi * br);
                const size_t ci = (size_t)((i * 32 + g) * 16 + p) * 64 + n;
                ct[(size_t)((i * 32 + g) * 16 + p) * 128 + n] = f2bf(args.in[16][ci]); ct[(size_t)((i * 32 + g) * 16 + p) * 128 + 64 + n] = f2bf(-args.in[17][ci]);
            }
        }
        for (int it = gt; it < 2 * 8 * 128 * 128; it += NGT) { const int r = (it >> 7) & 127, c = it & 127; ((bf16_t*)(ws + WS_WM))[it] = c <= r ? f2bf(args.in[22][it]) : (bf16_t)0; }
        for (int m = gw; m < MT; m += NGW) {
            const float* src = m < MP ? args.in[0] + (size_t)m * DM : args.in[1] + (size_t)(m - MP) * DM;
            float s = 0.f;
#pragma unroll
            for (int j = 0; j < 4; ++j) { const f32x4 v = ((const f32x4*)src)[lane + 64 * j]; s += (v[0] * v[0] + v[1] * v[1]) + (v[2] * v[2] + v[3] * v[3]);
                ((f32x4*)(H + (size_t)m * DM))[lane + 64 * j] = v; u32x2 w; w.x = cvt_pk_bf16(v[0], v[1]); w.y = cvt_pk_bf16(v[2], v[3]); ((u32x2*)(HB + (size_t)m * DM))[lane + 64 * j] = w; }
            s = wave_sum(s); if (lane < 16) ssq[((size_t)(lane >> 2) * MT + m) * 4 + (lane & 3)] = lane == 0 ? s : 0.f;
        }
    }
    PH_END

    for (int L = 0; L < DBG_LAYERS; ++L) {
        const int i = L >> 1; const bool even = (L & 1) == 0;
        PH_BEGIN
        {
            const int N = even ? 1536 : 2048;
            pg8::Gemm g{HB, (const bf16_t*)(ws + (even ? WS_W1E + i * 3 * MiB : WS_W1O + i * 4 * MiB)), MT, N, DM, DM, DM};
            pg8::StaticOrder S; S.init(MT, N, G, bx);
            pg8::EpiProj E{PROJ, PLD, ssq + (size_t)(2 * L) * MT * 16, even ? ssqv + (size_t)i * MT * 8 : nullptr, 1024};
            RUN_GEMM(pg8::EpiProj);
        }
        PH_END
        if (even) {
            PH_BEGIN
#if defined(DBG_NOMIX)
            { for (int it = gt; it < MT * 64; it += NGT) { const int m = it >> 6, c8 = it & 63; *(u32x4*)(MIX + (size_t)m * DM + 8 * c8) = *(const u32x4*)(PROJ + (size_t)m * PLD + 8 * c8); } }
#endif
            {
                MAKE_SC MAKE_GC
                for (int wu = gw; wu < 3840 + 1024; wu += NGW) {
                    if (wu < 3840) { const int g = wu & 31, bc = wu >> 5, b = bc / 15, c = bc % 15; s5_unit<false>(SC, (LAS float*)wreg, lane, b * SEQ + c * 128, g, false, b, c); }
                    else { const int su = wu - 3840, hd = su & 7, bc = su >> 3; sgu_unit(GC, (LAS bf16_t*)wreg, lane, bc * 128, hd); }
                }
                for (int it = gt; it < MSAMP * 64; it += NGT) {
                    const int sr = it >> 6, c8 = it & 63, col = 8 * c8, hd = col >> 6, b = sr >> 2, t = sr & 3;
                    float mix[8], vt[8];
#pragma unroll
                    for (int e = 0; e < 8; ++e) { mix[e] = 0.f; vt[e] = 0.f; }
                    const f32x4 g0 = *(const f32x4*)(GC.gnorm + col), g1 = *(const f32x4*)(GC.gnorm + col + 4);
                    for (int j = 0; j <= t; ++j) {
                        const size_t mj = (size_t)(MP + 4 * b + j); const f32x4 q0 = *(const f32x4*)(GC.ssqv + mj * 4), q1 = *(const f32x4*)(GC.ssqv + ((size_t)MT + mj) * 4); const float rs = rstd_of(((q0[0] + q0[1]) + (q0[2] + q0[3])) + ((q1[0] + q1[1]) + (q1[2] + q1[3])), 1.0f / 512);
                        const u32x4 v = *(const u32x4*)(PROJ + mj * PLD + 1024 + col);
                        float vn[8]; vn[0] = bf_lo(v.x) * rs * g0[0]; vn[1] = bf_hi(v.x) * rs * g0[1]; vn[2] = bf_lo(v.y) * rs * g0[2]; vn[3] = bf_hi(v.y) * rs * g0[3];
                        vn[4] = bf_lo(v.z) * rs * g1[0]; vn[5] = bf_hi(v.z) * rs * g1[1]; vn[6] = bf_lo(v.w) * rs * g1[2]; vn[7] = bf_hi(v.w) * rs * g1[3];
                        const float w = GC.sgu_w[(size_t)(hd * 128 + t) * 128 + j];
#pragma unroll
                        for (int e = 0; e < 8; ++e) { mix[e] += w * vn[e]; vt[e] = vn[e]; }
                    }
                    const float bias = GC.sgu_b[hd * 128 + t]; const size_t m = (size_t)(MP + sr);
                    const u32x4 uu = *(const u32x4*)(PROJ + m * PLD + 512 + col);
                    u32x4 w; w.x = cvt_pk_bf16(bf_lo(uu.x) * (mix[0] + bias), bf_hi(uu.x) * (mix[1] + bias)); w.y = cvt_pk_bf16(bf_lo(uu.y) * (mix[2] + bias), bf_hi(uu.y) * (mix[3] + bias));
                    w.z = cvt_pk_bf16(bf_lo(uu.z) * (mix[4] + bias), bf_hi(uu.z) * (mix[5] + bias)); w.w = cvt_pk_bf16(bf_lo(uu.w) * (mix[6] + bias), bf_hi(uu.w) * (mix[7] + bias));
                    *(u32x4*)(MIX + m * DM + 512 + col) = w;
                    float* sv = GC.s_v + (size_t)sr * 512 + col;
                    *(f32x4*)sv = (f32x4){vt[0], vt[1], vt[2], vt[3]}; *(f32x4*)(sv + 4) = (f32x4){vt[4], vt[5], vt[6], vt[7]};
                }
            }
            PH_END
            PH_BEGIN
            {
                const float* a128t = (const float*)(ws + WS_A128) + i * 2048; const float* sl = (const float*)(ws + WS_SLOC); float* car = (float*)(ws + WS_CAR);
                for (int it = gt; it < 8 * 32 * 64; it += NGT) {
                    const int b = it >> 11, gn = it & 2047; const float a128x = a128t[gn], a128y = a128t[4096 + gn]; float hr = 0.f, hi = 0.f;
                    for (int c = 0; c < 16; ++c) { car[(size_t)(b * 16 + c) * 2048 + gn] = hr; car[262144 + (size_t)(b * 16 + c) * 2048 + gn] = hi;
                        if (c < 15) { const float svx = sl[(size_t)(b * 16 + c) * 2048 + gn], svy = sl[262144 + (size_t)(b * 16 + c) * 2048 + gn]; const float nr = a128x * hr - a128y * hi + svx; hi = a128x * hi + a128y * hr + svy; hr = nr; } }
                }
            }
            PH_END
            PH_BEGIN
            {
                MAKE_SC
                for (int wu = gw; wu < 4096 + 128; wu += NGW) {
                    if (wu < 4096) { const int g = wu & 31, bc = wu >> 5, b = bc >> 4, c = bc & 15; s5_unit<true>(SC, (LAS float*)wreg, lane, b * SEQ + c * 128, g, false, b, c); }
                    else { const int su = wu - 4096, g = su & 31, sbk = su >> 5; s5_unit<true>(SC, (LAS float*)wreg, lane, MP + 128 * sbk, g, true, 32 * sbk, 0); }
                }
            }
            PH_END
            PH_BEGIN
#if defined(DBG_NOMIX)
            if (0)
#endif
            {
                pg8::Gemm g{PROJ + 1536, (const bf16_t*)(ws + WS_GLU + i * (MiB / 2)), MT, 512, 512, PLD, 512};
                pg8::StaticOrder S; S.init(MT, 512, G, bx);
                pg8::EpiGlu E{MIX, DM, PROJ + 1536, PLD, args.in[20] + i * 512};
                RUN_GEMM(pg8::EpiGlu);
            }
            PH_END
        } else {
            PH_BEGIN
#if defined(DBG_NOMIX_ODD)
            { for (int it = gt; it < MT * 128; it += NGT) { const int m = it >> 7, c8 = it & 127; *(u32x4*)(MIX + (size_t)m * DM + 8 * c8) = *(const u32x4*)(PROJ + (size_t)m * PLD + 8 * c8); } }
            if (0)
#endif
            {
                const float* spool = args.in[4] + (size_t)i * 128 * 15 * 512; const float* sconv = args.in[5] + (size_t)i * 128 * 2 * 512;
                const float* cw = args.in[28] + i * 3 * 512; const float* cb = args.in[29] + i * 512;
                float* ppool = args.out + O_PPOOL + (size_t)i * 8 * 15 * 512; float* pconv = args.out + O_PCONV + (size_t)i * 8 * 2 * 512;
                float* opool = args.out + O_SPOOL + (size_t)i * 128 * 15 * 512; float* oconv = args.out + O_SCONV + (size_t)i * 128 * 2 * 512;
                for (int it = gt; it < MT * 128; it += NGT) {
                    const int m = it >> 7, c8 = it & 127, col = 8 * c8; const bool samp = m >= MP;
                    const int b = samp ? (m - MP) >> 2 : m >> 11, t = samp ? (m - MP) & 3 : m & 2047;
                    if (col < 512) {
                        const int w = 2 << (col >> 7);
                        float s[8], x0[8];
#pragma unroll
                        for (int e = 0; e < 8; ++e) s[e] = 0.f;
                        int n = 0;
                        for (int k = 0; k < w; ++k) {
                            const int p = t - k;
                            if (p >= 0) { const u32x4 v = *(const u32x4*)(PROJ + (size_t)(m - k) * PLD + col);
                                float f[8]; f[0] = bf_lo(v.x); f[1] = bf_hi(v.x); f[2] = bf_lo(v.y); f[3] = bf_hi(v.y); f[4] = bf_lo(v.z); f[5] = bf_hi(v.z); f[6] = bf_lo(v.w); f[7] = bf_hi(v.w);
#pragma unroll
                                for (int e = 0; e < 8; ++e) { s[e] += f[e]; if (k == 0) x0[e] = f[e]; }
                                ++n; }
                            else if (samp) { const float* q = spool + (size_t)(b * 15 + 15 + p) * 512 + col; const f32x4 a0 = *(const f32x4*)q, a1 = *(const f32x4*)(q + 4);
                                s[0] += a0[0]; s[1] += a0[1]; s[2] += a0[2]; s[3] += a0[3]; s[4] += a1[0]; s[5] += a1[1]; s[6] += a1[2]; s[7] += a1[3]; ++n; }
                        }
                        const float inv = 1.0f / (float)n;
                        u32x4 o; o.x = cvt_pk_bf16(s[0] * inv - x0[0], s[1] * inv - x0[1]); o.y = cvt_pk_bf16(s[2] * inv - x0[2], s[3] * inv - x0[3]);
                        o.z = cvt_pk_bf16(s[4] * inv - x0[4], s[5] * inv - x0[5]); o.w = cvt_pk_bf16(s[6] * inv - x0[6], s[7] * inv - x0[7]);
                        *(u32x4*)(MIX + (size_t)m * DM + col) = o;
                        if (!samp) { if (t >= SEQ - 15) { float* q = ppool + (size_t)(b * 15 + t - (SEQ - 15)) * 512 + col; *(f32x4*)q = (f32x4){x0[0], x0[1], x0[2], x0[3]}; *(f32x4*)(q + 4) = (f32x4){x0[4], x0[5], x0[6], x0[7]}; } }
                        else { float* q = opool + (size_t)(b * 15 + 11 + t) * 512 + col; *(f32x4*)q = (f32x4){x0[0], x0[1], x0[2], x0[3]}; *(f32x4*)(q + 4) = (f32x4){x0[4], x0[5], x0[6], x0[7]};
                            if (t == 0) for (int r = 0; r < 11; ++r) { const float* sp = spool + (size_t)(b * 15 + r + 4) * 512 + col; float* dp = opool + (size_t)(b * 15 + r) * 512 + col;
                                *(f32x4*)dp = *(const f32x4*)sp; *(f32x4*)(dp + 4) = *(const f32x4*)(sp + 4); } }
                    } else {
                        const int d = col - 512;
                        float z[3][8];
#pragma unroll
                        for (int k = 0; k < 3; ++k) {
                            const int p = t - k;
                            if (p >= 0) { const u32x4 xv = *(const u32x4*)(PROJ + (size_t)(m - k) * PLD + 512 + d), cv = *(const u32x4*)(PROJ + (size_t)(m - k) * PLD + 1536 + d);
                                z[k][0] = bf_lo(xv.x) * bf_lo(cv.x); z[k][1] = bf_hi(xv.x) * bf_hi(cv.x); z[k][2] = bf_lo(xv.y) * bf_lo(cv.y); z[k][3] = bf_hi(xv.y) * bf_hi(cv.y);
                                z[k][4] = bf_lo(xv.z) * bf_lo(cv.z); z[k][5] = bf_hi(xv.z) * bf_hi(cv.z); z[k][6] = bf_lo(xv.w) * bf_lo(cv.w); z[k][7] = bf_hi(xv.w) * bf_hi(cv.w); }
                            else if (samp) { const float* q = sconv + (size_t)(b * 2 + 2 + p) * 512 + d; const f32x4 a0 = *(const f32x4*)q, a1 = *(const f32x4*)(q + 4);
                                z[k][0] = a0[0]; z[k][1] = a0[1]; z[k][2] = a0[2]; z[k][3] = a0[3]; z[k][4] = a1[0]; z[k][5] = a1[1]; z[k][6] = a1[2]; z[k][7] = a1[3]; }
                            else {
#pragma unroll
                                for (int e = 0; e < 8; ++e) z[k][e] = 0.f; }
                        }
                        const u32x4 bg = *(const u32x4*)(PROJ + (size_t)m * PLD + 1024 + d);
                        float bgf[8]; bgf[0] = bf_lo(bg.x); bgf[1] = bf_hi(bg.x); bgf[2] = bf_lo(bg.y); bgf[3] = bf_hi(bg.y); bgf[4] = bf_lo(bg.z); bgf[5] = bf_hi(bg.z); bgf[6] = bf_lo(bg.w); bgf[7] = bf_hi(bg.w);
                        float y[8];
#pragma unroll
                        for (int e = 0; e < 8; ++e) y[e] = bgf[e] * (cb[d + e] + z[2][e] * cw[d + e] + z[1][e] * cw[512 + d + e] + z[0][e] * cw[1024 + d + e]);
                        u32x4 o; o.x = cvt_pk_bf16(y[0], y[1]); o.y = cvt_pk_bf16(y[2], y[3]); o.z = cvt_pk_bf16(y[4], y[5]); o.w = cvt_pk_bf16(y[6], y[7]);
                        *(u32x4*)(MIX + (size_t)m * DM + col) = o;
                        float* q = nullptr;
                        if (!samp) { if (t >= SEQ - 2) q = pconv + (size_t)(b * 2 + t - (SEQ - 2)) * 512 + d; } else { if (t >= 2) q = oconv + (size_t)(b * 2 + t - 2) * 512 + d; }
                        if (q) { *(f32x4*)q = (f32x4){z[0][0], z[0][1], z[0][2], z[0][3]}; *(f32x4*)(q + 4) = (f32x4){z[0][4], z[0][5], z[0][6], z[0][7]}; }
                    }
                }
            }
            PH_END
        }
        PH_BEGIN
        {
            pg8::Gemm g{MIX, (const bf16_t*)(ws + (even ? WS_WOE : WS_WOO) + i * 2 * MiB), MT, DM, DM, DM, DM};
            pg8::StaticOrder S; S.init(MT, DM, G, bx);
            pg8::EpiResid E{H, HB, ssq + (size_t)(2 * L + 1) * MT * 16};
            RUN_GEMM(pg8::EpiResid);
        }
        PH_END
        PH_BEGIN
        {
            pg8::Gemm g{HB, (const bf16_t*)(ws + WS_WGU + L * 11 * MiB), MT, NGU, DM, DM, DM};
            pg8::StaticOrder S; S.init(MT, NGU, G, bx);
            pg8::EpiSwiglu E{ACT, ssq + (size_t)(2 * L + 1) * MT * 16};
            RUN_GEMM(pg8::EpiSwiglu);
        }
        PH_END
        PH_BEGIN
        {
            pg8::Gemm g{ACT, (const bf16_t*)(ws + WS_WD + L * (11 * MiB / 2)), MT, DM, FF, FF, FF};
            pg8::StaticOrder S; S.init(MT, DM, G, bx);
            pg8::EpiResid E{H, HB, ssq + (size_t)(2 * L + 2) * MT * 16};
            RUN_GEMM(pg8::EpiResid);
        }
        PH_END
    }
    PH_BEGIN
    {
        const float* sq = ssq + (size_t)8 * MT * 16; const f32x4* gf = (const f32x4*)args.in[8];
        for (int it = gt; it < MT * 256; it += NGT) { const int m = it >> 8, c4 = it & 255; const f32x4* q = (const f32x4*)sq + m; const f32x4 qa = q[0], qb = q[(size_t)MT], qc = q[(size_t)2 * MT], qd = q[(size_t)3 * MT];
            const float rs = rstd_of((((qa[0] + qa[1]) + (qa[2] + qa[3])) + ((qb[0] + qb[1]) + (qb[2] + qb[3]))) + (((qc[0] + qc[1]) + (qc[2] + qc[3])) + ((qd[0] + qd[1]) + (qd[2] + qd[3]))), 1.0f / DM);
            f32x4 v = ((f32x4*)H)[it]; const f32x4 gg = gf[c4]; v = v * rs * gg; ((f32x4*)H)[it] = v; }
    }
    PH_END
#if defined(DBG_MASK)
    PH_BEGIN
    {
        float* o = args.out; (void)ws;
        for (size_t it = (size_t)gt; it < O_END; it += NGT) {
            int cls;
            if (it < (size_t)MP * DM) cls = 0; else if (it < O_PRE) cls = 1; else if (it < O_PPOOL) cls = 2; else if (it < O_SRE) cls = 3; else if (it < O_SV) cls = 2; else if (it < O_SPOOL) cls = 4; else cls = 3;
            if ((DBG_MASK >> cls) & 1) o[it] = 0.f;
        }
    }
    PH_END
#endif
#undef PH_BEGIN
#undef PH_END
#if defined(DBG_STOP)
    if (lo == 99) {
        const int tid = threadIdx.x; unsigned char* ws = args.ws; float* o = args.out + O_SPOOL;
        const int NEL = (int)(O_END - O_SPOOL);
        for (int it = bx * 512 + tid; it < NEL; it += NGT) {
            float v;
            if (DBG_SRC == 0) { const int r = it >> 10, c = it & 1023; const int row = MP + (r % MSAMP); v = bf1(f2bf(args.out[(size_t)row * DM + c])); }
            else if (DBG_SRC == 1) { const int r = it >> 11, c = it & 2047; const int row = MP + (r % MSAMP); v = bf1(((const bf16_t*)(ws + WS_PROJ))[(size_t)row * PLD + c]); }
            else if (DBG_SRC == 2) { const int r = it >> 10, c = it & 1023; const int row = MP + (r % MSAMP); v = bf1(((const bf16_t*)(ws + WS_MIX))[(size_t)row * DM + c]); }
            else if (DBG_SRC == 5) { const int r = (it >> 11) % MSAMP, c = it & 2047; if (it >= MSAMP * 2048) { o[it] = 0.f; continue; }
                const bf16_t* a = (const bf16_t*)(ws + WS_HB) + (size_t)(MP + r) * DM; const bf16_t* w = (const bf16_t*)(ws + WS_W1O + 4 * MiB) + (size_t)c * DM; float acc = 0.f;
                for (int k = 0; k < DM; ++k) acc += bf1(a[k]) * bf1(w[k]);
                v = bf1(f2bf(acc)); }
            else if (DBG_SRC == 4) { const int r = it >> 10, c = it & 1023; const int row = MP + (r % MSAMP); v = bf1(((const bf16_t*)(ws + WS_HB))[(size_t)row * DM + c]); }
            else { const int r = it / FF, c = it % FF; const int row = MP + (r % MSAMP); v = bf1(((const bf16_t*)(ws + WS_ACT))[(size_t)row * FF + c]); }
            o[it] = v;
        }
    }
#endif
}

#if defined(DBG_MASK)
constexpr int N_PHASES = 1 + 2 * 8 + 2 * 5 + 2;
#else
constexpr int N_PHASES = 1 + 2 * 8 + 2 * 5 + 1;
#endif

extern "C" void kernel_launch(void* const* d_in, const int* in_sizes, int n_in, void* d_out, int out_size, void* d_ws, size_t ws_size, hipStream_t stream) {
    static int grid = 0;
    if (grid == 0) {
        if (n_in != 33 || out_size != (int)O_END || ws_size < WS_END) { fprintf(stderr, "kernel_launch: unexpected shapes n_in %d out %d ws %zu\n", n_in, out_size, ws_size); grid = -1; return; }
        int dev = 0, cus = 0, per_cu = 0;
        hipGetDevice(&dev); hipDeviceGetAttribute(&cus, hipDeviceAttributeMultiprocessorCount, dev);
        hipFuncSetAttribute((const void*)fwd_megakernel, hipFuncAttributeMaxDynamicSharedMemorySize, LDS_BYTES);
        hipOccupancyMaxActiveBlocksPerMultiprocessor(&per_cu, (const void*)fwd_megakernel, 512, LDS_BYTES);
        if (per_cu < 1) { fprintf(stderr, "kernel_launch: occupancy query says %d blocks per CU\n", per_cu); per_cu = 1; }
        (void)hipGetLastError();
        grid = cus;
    }
    if (grid < 0) return;
#if defined(DBG_FILLWS)
    (void)hipMemsetAsync((char*)d_ws + DBG_F0 * MiB, 0, (size_t)(DBG_F1 - DBG_F0) * MiB, stream); (void)hipMemsetAsync(d_out, 0, O_END * 4, stream);
#endif
#if defined(DBG_TINYSET)
    (void)hipMemsetAsync((char*)d_ws + 255 * MiB, 0, 256, stream); (void)hipMemsetAsync((char*)d_ws + 255 * MiB + 4096, 0, 256, stream);
#endif
    Args a{};
    for (int i = 0; i < 33; ++i) a.in[i] = (const float*)d_in[i];
    a.out = (float*)d_out; a.ws = (unsigned char*)d_ws;
#if MK_PER_PHASE
#if defined(DBG_STOP)
    for (int p = 0; p < DBG_STOP; ++p) { a.ph_lo = p; a.ph_hi = p + 1; hipLaunchKernelGGL(fwd_megakernel, dim3(grid), dim3(512), LDS_BYTES, stream, a); }
    a.ph_lo = 99; a.ph_hi = 100; hipLaunchKernelGGL(fwd_megakernel, dim3(grid), dim3(512), LDS_BYTES, stream, a);
#else
    for (int p = 0; p < N_PHASES; ++p) { a.ph_lo = p; a.ph_hi = p + 1; hipLaunchKernelGGL(fwd_megakernel, dim3(grid), dim3(512), LDS_BYTES, stream, a); }
#endif
#else
    a.ph_lo = 0; a.ph_hi = N_PHASES;
    void* kargs[] = {&a};
    hipError_t e = hipLaunchCooperativeKernel((const void*)fwd_megakernel, dim3(grid), dim3(512), kargs, LDS_BYTES, stream);
    if (e != hipSuccess) fprintf(stderr, "cooperative launch failed: %s (grid %d)\n", hipGetErrorString(e), grid);
#endif
}
```

```cpp
#include <hip/hip_runtime.h>
#include <hip/hip_cooperative_groups.h>
#include <cstdio>
#include <cstdint>
namespace cg = cooperative_groups;

#ifndef MK_PER_PHASE
#define MK_PER_PHASE 0
#endif

#ifndef DBG_LAYERS
#define DBG_LAYERS 4
#endif
#ifndef DBG_SKIP
#define DBG_SKIP 0
#endif
#define LAS __attribute__((address_space(3)))
typedef unsigned short bf16_t;
typedef short bf16x8 __attribute__((ext_vector_type(8)));
typedef float f32x2 __attribute__((ext_vector_type(2)));
typedef float f32x4 __attribute__((ext_vector_type(4)));
typedef float f32x16 __attribute__((ext_vector_type(16)));
typedef unsigned u32x4 __attribute__((ext_vector_type(4)));
typedef unsigned u32x2 __attribute__((ext_vector_type(2)));

constexpr int DM = 1024, MP = 16384, MSAMP = 512, MT = MP + MSAMP, FF = 2816, NGU = 2 * FF, SEQ = 2048;
constexpr float EPS = 1e-6f;
constexpr int PLD = 2048;
constexpr size_t O_Y = 0, O_PRE = 17301504, O_PIM = 17334272, O_PPOOL = 17367040, O_PCONV = 17489920, O_SRE = 17506304, O_SIM = 18030592,
                 O_SV = 18554880, O_SPOOL = 19079168, O_SCONV = 21045248, O_END = 21307392;
constexpr size_t MiB = 1u << 20;
constexpr size_t WS_SSQ = 226 * MiB, WS_SSQV = 237 * MiB;
constexpr size_t WS_ATAB = 1 * MiB, WS_A128 = WS_ATAB + 32768, WS_BBAR = WS_ATAB + 65536, WS_CTAB = WS_BBAR + 262144, WS_WM = WS_CTAB + 262144;
constexpr size_t WS_SLOC = 3 * MiB;
constexpr size_t WS_W1E = 5 * MiB, WS_WOE = 11 * MiB, WS_GLU = 15 * MiB, WS_W1O = 16 * MiB, WS_WOO = 24 * MiB, WS_WGU = 28 * MiB, WS_WD = 72 * MiB;
constexpr size_t WS_HB = 94 * MiB, WS_PROJ = 127 * MiB, WS_MIX = 193 * MiB, WS_ACT = 127 * MiB, WS_ACT_END = 226 * MiB, WS_CAR = 239 * MiB, WS_END = 241 * MiB;
static_assert(WS_WM + 524288 <= WS_SLOC && WS_SSQ + 9 * (size_t)MT * 64 <= WS_SSQV && WS_SSQV + 2 * (size_t)MT * 32 <= 239 * MiB, "ws map");
static_assert(WS_ACT + (size_t)MT * FF * 2 <= WS_ACT_END, "act overlay");

constexpr int LDS_BYTES = 147456;
constexpr int WREG = 17408;

typedef __bf16 bf16x2_t __attribute__((ext_vector_type(2)));
__device__ __forceinline__ unsigned cvt_pk_bf16(float lo, float hi) { const f32x2 v = {lo, hi}; const bf16x2_t b = __builtin_convertvector(v, bf16x2_t); return __builtin_bit_cast(unsigned, b); }
__device__ __forceinline__ float bf_lo(unsigned w) { return __uint_as_float(w << 16); }
__device__ __forceinline__ float bf_hi(unsigned w) { return __uint_as_float(w & 0xffff0000u); }
__device__ __forceinline__ float bf1(bf16_t b) { return __uint_as_float((unsigned)b << 16); }
__device__ __forceinline__ bf16_t f2bf(float f) { return (bf16_t)(cvt_pk_bf16(f, 0.f) & 0xffffu); }
__device__ __forceinline__ float rstd_of(float ssq, float invn) { return rsqrtf(ssq * invn + EPS); }
__device__ __forceinline__ float sigmoidf_(float x) { return __builtin_amdgcn_rcpf(1.0f + __expf(-x)); }
#define LDS_WAIT() asm volatile("s_waitcnt lgkmcnt(0)" ::: "memory")
__device__ __forceinline__ float row_ssq16(const float* part, int row, int fq) { const f32x4 p = *(const f32x4*)(part + ((size_t)fq * MT + row) * 4);     float s = (p[0] + p[1]) + (p[2] + p[3]); s += __shfl_xor(s, 16); s += __shfl_xor(s, 32); return s; }
__device__ __forceinline__ int launder_v(int x) { asm volatile("" : "+v"(x)); return x; }
__device__ __forceinline__ size_t launder_zero() { size_t z = 0; asm volatile("" : "+s"(z)); return z; }

namespace pg8 {
constexpr int BM = 256, BK = 64, HALF = 128, HTB = HALF * BK * 2, STAGE_BYTES = 8 * HTB, NXCD = 8, WGM = 8;
__host__ __device__ __forceinline__ int lds_byte(int r, int c) { const int st = (r >> 4) * 2 + (c >> 5), rr = r & 15, cc = c & 31, ob = rr * 64 + cc * 2; return st * 1024 + (ob ^ (((ob >> 9) & 1) << 5)); }
__host__ __device__ __forceinline__ void stage_rc(int b, int& R, int& C) { const int st = b / 1024, sb = b % 1024, swz = sb ^ (((sb >> 9) & 1) << 5); R = (st >> 1) * 16 + swz / 64; C = (st & 1) * 32 + (swz % 64) / 2; }
__host__ __device__ __forceinline__ int perm32(int rho) { const int n = rho >> 4, i = rho & 15; return 8 * (i >> 2) + 4 * n + (i & 3); }
struct Unit { int pm, pn; };
struct Gemm { const bf16_t* A; const bf16_t* Bt; int M, N, K, lda, ldb; };
struct StaticOrder {
    int nM, nN, nwg, G, c;
    __device__ void init(int M, int N, int G_, int c_) { nM = M / BM; nN = N / BM; nwg = nM * nN; G = G_; c = c_; }
    __device__ bool next(int i, Unit& u) const {
        const long L = (long)i * G + c; if (L >= nwg) return false;
        int wgid = (int)L; { const int q = nwg / NXCD, r = nwg % NXCD, xcd = wgid % NXCD, off = wgid / NXCD; wgid = (xcd < r ? xcd * (q + 1) : r * (q + 1) + (xcd - r) * q) + off; }
        const int nig = WGM * nN, gid = wgid / nig, fm = gid * WGM, gsz = (nM - fm) < WGM ? (nM - fm) : WGM;
        u.pm = fm + ((wgid % nig) % gsz); u.pn = (wgid % nig) / gsz; return true;
    }
};

struct EpiProj {
    bf16_t* O; int ldc; const float* ssq_in; float* ssq_v; int vcol0;
    __device__ __forceinline__ void operator()(const f32x4 (&acc)[2][2][4][2], const Unit& u, int wr, int wc, int fr, int fq) const {
        const int row0 = u.pm * BM + wr * 64 + fr, col0 = u.pn * BM + wc * 32 + 8 * fq;
        const bool dov = (ssq_v != nullptr) && (u.pn * BM >= vcol0);
#pragma unroll
        for (int ai = 0; ai < 2; ++ai)
#pragma unroll
            for (int m = 0; m < 4; ++m) {
                const int row = row0 + ai * HALF + m * 16;
#if defined(DBG_NORS)
                const float rs = 1.0f;
#else
                const float rs = rstd_of(row_ssq16(ssq_in, row, fq), 1.0f / DM);
#endif
                float sq = 0.f;
#pragma unroll
                for (int bj = 0; bj < 2; ++bj) { const f32x4 v0 = acc[ai][bj][m][0] * rs, v1 = acc[ai][bj][m][1] * rs;
                    u32x4 w; w.x = cvt_pk_bf16(v0[0], v0[1]); w.y = cvt_pk_bf16(v0[2], v0[3]); w.z = cvt_pk_bf16(v1[0], v1[1]); w.w = cvt_pk_bf16(v1[2], v1[3]);
                    *(u32x4*)(O + (size_t)row * ldc + col0 + bj * HALF) = w;
                    sq += (v0[0] * v0[0] + v0[1] * v0[1]) + (v0[2] * v0[2] + v0[3] * v0[3]) + (v1[0] * v1[0] + v1[1] * v1[1]) + (v1[2] * v1[2] + v1[3] * v1[3]); }
                if (dov) { sq += __shfl_xor(sq, 16); sq += __shfl_xor(sq, 32); if (fq == 0) ssq_v[((size_t)(u.pn - vcol0 / BM) * MT + row) * 4 + wc] = sq; }
            }
    }
};
struct EpiGlu {
    bf16_t* O; int ldc; const bf16_t* Z; int ldz; const float* bias;
    __device__ __forceinline__ void operator()(const f32x4 (&acc)[2][2][4][2], const Unit& u, int wr, int wc, int fr, int fq) const {
        const int row0 = u.pm * BM + wr * 64 + fr, col0 = u.pn * BM + wc * 32 + 8 * fq;
        f32x4 bv[2][2];
#pragma unroll
        for (int bj = 0; bj < 2; ++bj)
#pragma unroll
            for (int n = 0; n < 2; ++n) bv[bj][n] = *(const f32x4*)(bias + col0 + bj * HALF + 4 * n);
#pragma unroll
        for (int ai = 0; ai < 2; ++ai)
#pragma unroll
            for (int m = 0; m < 4; ++m) {
                const int row = row0 + ai * HALF + m * 16;
#pragma unroll
                for (int bj = 0; bj < 2; ++bj) { const u32x4 z = *(const u32x4*)(Z + (size_t)row * ldz + col0 + bj * HALF);
                    const f32x4 g0 = acc[ai][bj][m][0] + bv[bj][0], g1 = acc[ai][bj][m][1] + bv[bj][1];
                    u32x4 w;
                    w.x = cvt_pk_bf16(bf_lo(z.x) * sigmoidf_(g0[0]), bf_hi(z.x) * sigmoidf_(g0[1])); w.y = cvt_pk_bf16(bf_lo(z.y) * sigmoidf_(g0[2]), bf_hi(z.y) * sigmoidf_(g0[3]));
                    w.z = cvt_pk_bf16(bf_lo(z.z) * sigmoidf_(g1[0]), bf_hi(z.z) * sigmoidf_(g1[1])); w.w = cvt_pk_bf16(bf_lo(z.w) * sigmoidf_(g1[2]), bf_hi(z.w) * sigmoidf_(g1[3]));
                    *(u32x4*)(O + (size_t)row * ldc + col0 + bj * HALF) = w; }
            }
    }
};
struct EpiResid {
    float* H; bf16_t* HB; float* ssq_out;
    __device__ __forceinline__ void operator()(const f32x4 (&acc)[2][2][4][2], const Unit& u, int wr, int wc, int fr, int fq) const {
        const int row0 = u.pm * BM + wr * 64 + fr, col0 = u.pn * BM + wc * 32 + 8 * fq;
#pragma unroll
        for (int ai = 0; ai < 2; ++ai)
#pragma unroll
            for (int m = 0; m < 4; ++m) {
                const int row = row0 + ai * HALF + m * 16; float sq = 0.f;
#pragma unroll
                for (int bj = 0; bj < 2; ++bj) { float* hp = H + (size_t)row * DM + col0 + bj * HALF;
                    const f32x4 v0 = *(const f32x4*)hp + acc[ai][bj][m][0], v1 = *(const f32x4*)(hp + 4) + acc[ai][bj][m][1];
                    *(f32x4*)hp = v0; *(f32x4*)(hp + 4) = v1;
                    u32x4 w; w.x = cvt_pk_bf16(v0[0], v0[1]); w.y = cvt_pk_bf16(v0[2], v0[3]); w.z = cvt_pk_bf16(v1[0], v1[1]); w.w = cvt_pk_bf16(v1[2], v1[3]);
                    *(u32x4*)(HB + (size_t)row * DM + col0 + bj * HALF) = w;
                    sq += (v0[0] * v0[0] + v0[1] * v0[1]) + (v0[2] * v0[2] + v0[3] * v0[3]) + (v1[0] * v1[0] + v1[1] * v1[1]) + (v1[2] * v1[2] + v1[3] * v1[3]); }
                sq += __shfl_xor(sq, 16); sq += __shfl_xor(sq, 32); if (fq == 0) ssq_out[((size_t)u.pn * MT + row) * 4 + wc] = sq;
                if (m & 1) asm volatile("" ::: "memory");
            }
    }
};
struct EpiSwiglu {
    bf16_t* O; const float* ssq_in;
    __device__ __forceinline__ void operator()(const f32x4 (&acc)[2][2][4][2], const Unit& u, int wr, int wc, int fr, int fq) const {
        const int row0 = u.pm * BM + wr * 64 + fr, col0 = u.pn * HALF + wc * 32 + 8 * fq;
#pragma unroll
        for (int ai = 0; ai < 2; ++ai)
#pragma unroll
            for (int m = 0; m < 4; ++m) {
                const int row = row0 + ai * HALF + m * 16; const float rs = rstd_of(row_ssq16(ssq_in, row, fq), 1.0f / DM);
                const f32x4 g0 = acc[ai][0][m][0] * rs, g1 = acc[ai][0][m][1] * rs, u0 = acc[ai][1][m][0] * rs, u1 = acc[ai][1][m][1] * rs;
                u32x4 w;
                w.x = cvt_pk_bf16(g0[0] * sigmoidf_(g0[0]) * u0[0], g0[1] * sigmoidf_(g0[1]) * u0[1]); w.y = cvt_pk_bf16(g0[2] * sigmoidf_(g0[2]) * u0[2], g0[3] * sigmoidf_(g0[3]) * u0[3]);
                w.z = cvt_pk_bf16(g1[0] * sigmoidf_(g1[0]) * u1[0], g1[1] * sigmoidf_(g1[1]) * u1[1]); w.w = cvt_pk_bf16(g1[2] * sigmoidf_(g1[2]) * u1[2], g1[3] * sigmoidf_(g1[3]) * u1[3]);
                *(u32x4*)(O + (size_t)row * FF + col0) = w;
            }
    }
};

struct OneUnit { Unit u; __device__ bool next(int i, Unit& o) const { if (i != 0) return false; o = u; return true; } };
template <class Epi, bool ALIGN_EPI = true, class Sched = StaticOrder>
__device__ __forceinline__ void gemm_phase(LAS unsigned char* lds, const Gemm g, const Sched& S, const Epi& E) {
    const int tid = launder_v(threadIdx.x), wid = __builtin_amdgcn_readfirstlane(tid >> 6), lane = tid & 63, wr = wid >> 2, wc = wid & 3, fr = lane & 15, fq = lane >> 4;
    const int K = g.K, nt = K / BK;
    unsigned voffA[2], voffB[2];
#pragma unroll
    for (int i = 0; i < 2; ++i) { int R, C; stage_rc(tid * 16 + i * 8192, R, C); const int Rb = (R & ~31) + perm32(R & 31);
        voffA[i] = (unsigned)(R * g.lda + C) * 2u; voffB[i] = (unsigned)(Rb * g.ldb + C) * 2u; }
    const size_t kstep = (size_t)(BK * 2);
    const size_t hstepA = (size_t)HALF * g.lda * 2, hstepB = (size_t)HALF * g.ldb * 2;
    const size_t tstepA = 2 * hstepA, tstepB = 2 * hstepB;
    const unsigned ldsw = (unsigned)wid * 1024u;
    const int aoff = lds_byte(wr * 64 + fr, fq * 8), boff = lds_byte(wc * 32 + fr, fq * 8);
#define PG8_SA(b, h) (((b) * 2 + (h)) * HTB)
#define PG8_SB(b, h) ((4 + (b) * 2 + (h)) * HTB)
#define PG8_STAGE(bufoff, gbase, voff) do { _Pragma("unroll") for (int _i = 0; _i < 2; ++_i) \
        __builtin_amdgcn_global_load_lds((const unsigned*)((const char*)(gbase) + (voff)[_i]), (LAS unsigned*)(lds + (bufoff) + ldsw + _i * 8192), 16, 0, 0); } while (0)
#define PG8_LDA(dst, b, h) do { _Pragma("unroll") for (int m = 0; m < 4; ++m) _Pragma("unroll") for (int k = 0; k < 2; ++k) dst[m][k] = *(const LAS bf16x8*)(lds + PG8_SA(b, h) + aoff + m * 2048 + k * 1024); } while (0)
#define PG8_LDB(dst, b, h) do { _Pragma("unroll") for (int n = 0; n < 2; ++n) _Pragma("unroll") for (int k = 0; k < 2; ++k) dst[n][k] = *(const LAS bf16x8*)(lds + PG8_SB(b, h) + boff + n * 2048 + k * 1024); } while (0)
#define PG8_MMA(ai, bj, At, Bt) do { __builtin_amdgcn_s_setprio(1); _Pragma("unroll") for (int m = 0; m < 4; ++m) _Pragma("unroll") for (int n = 0; n < 2; ++n) _Pragma("unroll") for (int k = 0; k < 2; ++k) \
        acc[ai][bj][m][n] = __builtin_amdgcn_mfma_f32_16x16x32_bf16(Bt[n][k], At[m][k], acc[ai][bj][m][n], 0, 0, 0); __builtin_amdgcn_s_setprio(0); } while (0)
#define PG8_WAIT_V(n) asm volatile("s_waitcnt vmcnt(" #n ")" ::: "memory")
#define PG8_WAIT_L(n) asm volatile("s_waitcnt lgkmcnt(" #n ")" ::: "memory")
#define PG8_BAR __builtin_amdgcn_s_barrier()
#define PG8_SCHED __builtin_amdgcn_sched_barrier(0)
    Unit cur, nxt; int ui = 0;
    if (!S.next(0, cur)) return;
    f32x4 acc[2][2][4][2];
#pragma unroll
    for (int a = 0; a < 2; ++a)
#pragma unroll
        for (int b = 0; b < 2; ++b)
#pragma unroll
            for (int m = 0; m < 4; ++m)
#pragma unroll
                for (int n = 0; n < 2; ++n) acc[a][b][m][n] = (f32x4){0.f, 0.f, 0.f, 0.f};
    bf16x8 At[4][2], B0[2][2], B1[2][2];
    const char* cA = (const char*)g.A + (size_t)cur.pm * tstepA; const char* cB = (const char*)g.Bt + (size_t)cur.pn * tstepB;
    PG8_STAGE(PG8_SB(0, 0), cB, voffB); PG8_STAGE(PG8_SB(0, 1), cB + hstepB, voffB); PG8_STAGE(PG8_SA(0, 0), cA, voffA); PG8_STAGE(PG8_SA(0, 1), cA + hstepA, voffA);
    if (wr == 1) PG8_BAR;
    PG8_WAIT_V(2); PG8_BAR;
    PG8_STAGE(PG8_SB(1, 0), cB + kstep, voffB); PG8_STAGE(PG8_SA(1, 0), cA + kstep, voffA); PG8_STAGE(PG8_SB(1, 1), cB + hstepB + kstep, voffB);
    PG8_WAIT_V(6); PG8_BAR;
    for (;;) {
        const bool has_next = S.next(ui + 1, nxt);
        const char* nA = has_next ? (const char*)g.A + (size_t)nxt.pm * tstepA : cA; const char* nB = has_next ? (const char*)g.Bt + (size_t)nxt.pn * tstepB : cB;
        for (int t = 0; t < nt; t += 2) {
            const bool last = (t == nt - 2);
            const char* a1 = cA + (size_t)(t + 1) * kstep;
            const char* a2 = last ? nA : cA + (size_t)(t + 2) * kstep; const char* b2 = last ? nB : cB + (size_t)(t + 2) * kstep;
            const char* a3 = a2 + kstep; const char* b3 = b2 + kstep;
            PG8_LDB(B0, 0, 0); PG8_LDB(B1, 0, 1); PG8_SCHED; PG8_LDA(At, 0, 0); PG8_STAGE(PG8_SA(1, 1), a1 + hstepA, voffA);
            PG8_WAIT_V(8); PG8_WAIT_L(0); PG8_BAR; PG8_MMA(0, 0, At, B0); PG8_MMA(0, 1, At, B1); PG8_BAR; PG8_SCHED;
            PG8_LDA(At, 0, 1); PG8_STAGE(PG8_SB(0, 0), b2, voffB); PG8_STAGE(PG8_SB(0, 1), b2 + hstepB, voffB); PG8_STAGE(PG8_SA(0, 0), a2, voffA);
            PG8_WAIT_V(8); PG8_WAIT_L(0); PG8_BAR; PG8_MMA(1, 0, At, B0); PG8_MMA(1, 1, At, B1); PG8_BAR; PG8_SCHED;
            PG8_LDB(B0, 1, 0); PG8_LDB(B1, 1, 1); PG8_SCHED; PG8_LDA(At, 1, 0); PG8_STAGE(PG8_SA(0, 1), a2 + hstepA, voffA);
            PG8_WAIT_V(8); PG8_WAIT_L(0); PG8_BAR; PG8_MMA(0, 0, At, B0); PG8_MMA(0, 1, At, B1); PG8_BAR; PG8_SCHED;
            PG8_LDA(At, 1, 1); PG8_STAGE(PG8_SB(1, 0), b3, voffB); PG8_STAGE(PG8_SB(1, 1), b3 + hstepB, voffB); PG8_STAGE(PG8_SA(1, 0), a3, voffA);
            PG8_WAIT_V(8); PG8_WAIT_L(0); PG8_BAR; PG8_MMA(1, 0, At, B0); PG8_MMA(1, 1, At, B1); PG8_BAR; PG8_SCHED;
        }
        if constexpr (ALIGN_EPI) { if (wr == 0) PG8_BAR; }
        E(acc, cur, wr, wc, fr, fq);
        if (!has_next) break;
#pragma unroll
        for (int a = 0; a < 2; ++a)
#pragma unroll
            for (int b = 0; b < 2; ++b)
#pragma unroll
                for (int m = 0; m < 4; ++m)
#pragma unroll
                    for (int n = 0; n < 2; ++n) acc[a][b][m][n] = (f32x4){0.f, 0.f, 0.f, 0.f};
        cur = nxt; cA = nA; cB = nB; ++ui;
        if constexpr (ALIGN_EPI) { if (wr == 1) PG8_BAR; }
    }
    PG8_WAIT_V(0);
    if constexpr (!ALIGN_EPI) { if (wr == 0) PG8_BAR; }
    PG8_BAR;
#undef PG8_SA
#undef PG8_SB
#undef PG8_STAGE
#undef PG8_LDA
#undef PG8_LDB
#undef PG8_MMA
#undef PG8_WAIT_V
#undef PG8_WAIT_L
#undef PG8_BAR
#undef PG8_SCHED
}

template <class Epi>
__device__ __forceinline__ void gemm_unit_rs(LAS unsigned char* lds, const Gemm g, const Unit cur, const Epi& E) {
    const int tid = launder_v(threadIdx.x), wid = __builtin_amdgcn_readfirstlane(tid >> 6), lane = tid & 63, wr = wid >> 2, wc = wid & 3, fr = lane & 15, fq = lane >> 4;
    const int nt = g.K / BK;
    unsigned voffA[2], voffB[2];
#pragma unroll
    for (int i = 0; i < 2; ++i) { int R, C; stage_rc(tid * 16 + i * 8192, R, C); const int Rb = (R & ~31) + perm32(R & 31);
        voffA[i] = (unsigned)(R * g.lda + C) * 2u; voffB[i] = (unsigned)(Rb * g.ldb + C) * 2u; }
    const size_t hstepA = (size_t)HALF * g.lda * 2, hstepB = (size_t)HALF * g.ldb * 2;
    const char* cA = (const char*)g.A + (size_t)cur.pm * 2 * hstepA; const char* cB = (const char*)g.Bt + (size_t)cur.pn * 2 * hstepB;
    const int aoff = lds_byte(wr * 64 + fr, fq * 8), boff = lds_byte(wc * 32 + fr, fq * 8);
    const unsigned wofs = (unsigned)tid * 16u;
    f32x4 acc[2][2][4][2];
#pragma unroll
    for (int a = 0; a < 2; ++a)
#pragma unroll
        for (int b = 0; b < 2; ++b)
#pragma unroll
            for (int m = 0; m < 4; ++m)
#pragma unroll
                for (int n = 0; n < 2; ++n) acc[a][b][m][n] = (f32x4){0.f, 0.f, 0.f, 0.f};
    u32x4 st[8];
#define RS_LOAD(kt) do { const char* a_ = cA + (size_t)(kt) * (BK * 2); const char* b_ = cB + (size_t)(kt) * (BK * 2); \
        _Pragma("unroll") for (int h = 0; h < 2; ++h) _Pragma("unroll") for (int i = 0; i < 2; ++i) { \
            st[h * 2 + i] = *(const u32x4*)(a_ + h * hstepA + voffA[i]); st[4 + h * 2 + i] = *(const u32x4*)(b_ + h * hstepB + voffB[i]); } } while (0)
#define RS_STORE(buf) do { _Pragma("unroll") for (int h = 0; h < 2; ++h) _Pragma("unroll") for (int i = 0; i < 2; ++i) { \
            *(LAS u32x4*)(lds + ((buf) * 2 + h) * HTB + i * 8192 + wofs) = st[h * 2 + i]; *(LAS u32x4*)(lds + (4 + (buf) * 2 + h) * HTB + i * 8192 + wofs) = st[4 + h * 2 + i]; } } while (0)
    RS_LOAD(0); RS_STORE(0); __syncthreads();
    for (int kt = 0; kt < nt; ++kt) {
        const int b = kt & 1;
        if (kt + 1 < nt) RS_LOAD(kt + 1);
        __builtin_amdgcn_sched_barrier(0);
        bf16x8 B0[2][2], B1[2][2], At[4][2];
#pragma unroll
        for (int n = 0; n < 2; ++n)
#pragma unroll
            for (int k = 0; k < 2; ++k) { B0[n][k] = *(const LAS bf16x8*)(lds + (4 + b * 2 + 0) * HTB + boff + n * 2048 + k * 1024); B1[n][k] = *(const LAS bf16x8*)(lds + (4 + b * 2 + 1) * HTB + boff + n * 2048 + k * 1024); }
#pragma unroll
        for (int ai = 0; ai < 2; ++ai) {
#pragma unroll
            for (int m = 0; m < 4; ++m)
#pragma unroll
                for (int k = 0; k < 2; ++k) At[m][k] = *(const LAS bf16x8*)(lds + (b * 2 + ai) * HTB + aoff + m * 2048 + k * 1024);
#pragma unroll
            for (int m = 0; m < 4; ++m)
#pragma unroll
                for (int n = 0; n < 2; ++n)
#pragma unroll
                    for (int k = 0; k < 2; ++k) { acc[ai][0][m][n] = __builtin_amdgcn_mfma_f32_16x16x32_bf16(B0[n][k], At[m][k], acc[ai][0][m][n], 0, 0, 0);
                                                  acc[ai][1][m][n] = __builtin_amdgcn_mfma_f32_16x16x32_bf16(B1[n][k], At[m][k], acc[ai][1][m][n], 0, 0, 0); }
        }
        __builtin_amdgcn_sched_barrier(0);
        if (kt + 1 < nt) RS_STORE(b ^ 1);
        __syncthreads();
    }
#undef RS_LOAD
#undef RS_STORE
    E(acc, cur, wr, wc, fr, fq);
}
}

__device__ __forceinline__ float wave_sum(float v) {
#pragma unroll
    for (int o = 1; o < 64; o <<= 1) v += __shfl_xor(v, o);
    return v;
}
__device__ __forceinline__ void xpose_mat(const float* __restrict__ W, int ldw, int K, int N, bf16_t* dst, int ldt, int dcol0, const float* __restrict__ gain, int mapmode,
                                          LAS float* scr, int gw, int NGW, int lane) {
    const int nblk = N / 32, nit = (K / 64) * nblk;
    for (int it = gw; it < nit; it += NGW) {
        const int kb = it / nblk, nb = it % nblk, k0 = 64 * kb, n0 = 32 * nb;
#pragma unroll 8
        for (int i = 0; i < 32; ++i) { const int kk = 2 * i + (lane >> 5); float w = W[(size_t)(k0 + kk) * ldw + n0 + (lane & 31)]; if (gain) w *= gain[k0 + kk]; scr[kk * 33 + (lane & 31)] = w; }
        LDS_WAIT();
        const int c = lane & 7;
#pragma unroll
        for (int j = 0; j < 4; ++j) { const int n = (lane >> 3) + 8 * j; const LAS float* s = scr + (8 * c) * 33 + n;
            u32x4 o; o.x = cvt_pk_bf16(s[0 * 33], s[1 * 33]); o.y = cvt_pk_bf16(s[2 * 33], s[3 * 33]); o.z = cvt_pk_bf16(s[4 * 33], s[5 * 33]); o.w = cvt_pk_bf16(s[6 * 33], s[7 * 33]);
            const int nn = n0 + n; const int row = mapmode == 0 ? nn : (256 * (nn >> 7) + (nn & 127) + (mapmode == 2 ? 128 : 0));
            *(u32x4*)(dst + (size_t)row * ldt + dcol0 + k0 + 8 * c) = o; }
        LDS_WAIT();
    }
}
__device__ __forceinline__ void sincos_d(double x, double& s, double& c) {
    const double q = __builtin_rint(x * 0.63661977236758134308), r = (x - q * 1.57079632679489655800) - q * 6.12323399573676603587e-17;
    const double r2 = r * r;
    double sp = r * (1.0 + r2 * (-1.0 / 6 + r2 * (1.0 / 120 + r2 * (-1.0 / 5040 + r2 * (1.0 / 362880 + r2 * (-1.0 / 39916800 + r2 * (1.0 / 6227020800.0)))))));
    double cp = 1.0 + r2 * (-0.5 + r2 * (1.0 / 24 + r2 * (-1.0 / 720 + r2 * (1.0 / 40320 + r2 * (-1.0 / 3628800 + r2 * (1.0 / 479001600 + r2 * (-1.0 / 87178291200.0)))))));
    const int qi = ((int)q) & 3;
    s = (qi == 0) ? sp : (qi == 1) ? cp : (qi == 2) ? -sp : -cp;
    c = (qi == 0) ? cp : (qi == 1) ? -sp : (qi == 2) ? -cp : sp;
}

struct Args { const float* in[33]; float* out; unsigned char* ws; int ph_lo, ph_hi; };

struct S5Ctx { const bf16_t* PROJ; bf16_t* PROJw; const f32x2* Atab; const f32x2* A128; const bf16_t* Bbar; const bf16_t* Ctab; const float* Dsk; f32x2* Sloc; const f32x2* Car;
               const float* st_re; const float* st_im; float* p_re; float* p_im; float* s_re; float* s_im; };

template <bool PASSB>
__device__ __forceinline__ void s5_unit(const S5Ctx& S, LAS float* X, int lane, int m0, int g, bool sample, int b, int c) {
    const int l31 = lane & 31, lh = lane >> 5, l15 = lane & 15, lq = lane >> 4;
    bf16x8 Bf[4];
#pragma unroll
    for (int sb = 0; sb < 4; ++sb) Bf[sb] = *(const bf16x8*)(S.Bbar + ((g * 128 + 32 * sb + l31) * 16 + 8 * lh));
    const f32x2 a = {((const float*)S.Atab)[g * 64 + lane], ((const float*)S.Atab)[4096 + g * 64 + lane]};
    bf16x8 Cf[4]; f32x4 Dv = (f32x4){0.f, 0.f, 0.f, 0.f};
    if (PASSB) {
#pragma unroll
        for (int ks = 0; ks < 4; ++ks) Cf[ks] = *(const bf16x8*)(S.Ctab + ((g * 16 + l15) * 128 + 32 * ks + 8 * lq));
        Dv = *(const f32x4*)(S.Dsk + g * 16 + 4 * lq);
    }
    float hr = 0.f, hi = 0.f;
    if (PASSB && !sample && c > 0) { const float* cp = (const float*)S.Car + (size_t)((b * 16 + c) * 32 + g) * 64 + lane; hr = cp[0]; hi = cp[262144]; }
    for (int tb = 0; tb < 4; ++tb) {
        const bf16x8 Af = *(const bf16x8*)(S.PROJ + (size_t)(m0 + 32 * tb + l31) * PLD + g * 16 + 8 * lh);
#pragma unroll
        for (int sb = 0; sb < 4; ++sb) {
            f32x16 acc;
#pragma unroll
            for (int r = 0; r < 16; ++r) acc[r] = 0.f;
            acc = __builtin_amdgcn_mfma_f32_32x32x16_bf16(Af, Bf[sb], acc, 0, 0, 0);
#pragma unroll
            for (int r = 0; r < 16; ++r) X[(8 * (r >> 2) + 4 * lh + (r & 3)) * 132 + 32 * sb + l31] = acc[r];
        }
        LDS_WAIT();
#pragma unroll 8
        for (int t = 0; t < 32; ++t) {
            if (sample && (t & 3) == 0) { const int bi = b + ((32 * tb + t) >> 2); hr = S.st_re[(size_t)(bi * 32 + g) * 64 + lane]; hi = S.st_im[(size_t)(bi * 32 + g) * 64 + lane]; }
            const float xr = X[t * 132 + lane], xi = X[t * 132 + 64 + lane];
            const float nr = a.x * hr - a.y * hi + xr, ni = a.x * hi + a.y * hr + xi; hr = nr; hi = ni;
            if (PASSB) { X[t * 132 + lane] = hr; X[t * 132 + 64 + lane] = hi; }
            if (PASSB && sample && (t & 3) == 3) { const int bi = b + ((32 * tb + t) >> 2); S.s_re[(size_t)(bi * 32 + g) * 64 + lane] = hr; S.s_im[(size_t)(bi * 32 + g) * 64 + lane] = hi; }
        }
        LDS_WAIT();
        if (PASSB) {
#pragma unroll
            for (int tb2 = 0; tb2 < 2; ++tb2) {
                f32x4 acc = (f32x4){0.f, 0.f, 0.f, 0.f};
#pragma unroll
                for (int ks = 0; ks < 4; ++ks) { const LAS float* hp = X + (16 * tb2 + l15) * 132 + 32 * ks + 8 * lq;
                    const f32x4 h0 = *(const LAS f32x4*)hp, h1 = *(const LAS f32x4*)(hp + 4);
                    u32x4 hw; hw.x = cvt_pk_bf16(h0[0], h0[1]); hw.y = cvt_pk_bf16(h0[2], h0[3]); hw.z = cvt_pk_bf16(h1[0], h1[1]); hw.w = cvt_pk_bf16(h1[2], h1[3]);
                    acc = __builtin_amdgcn_mfma_f32_16x16x32_bf16(Cf[ks], __builtin_bit_cast(bf16x8, hw), acc, 0, 0, 0); }
                const size_t m = (size_t)(m0 + 32 * tb + 16 * tb2 + l15);
                const u32x2 uu = *(const u32x2*)(S.PROJ + m * PLD + g * 16 + 4 * lq);
                float y[4]; y[0] = acc[0] + Dv[0] * bf_lo(uu.x); y[1] = acc[1] + Dv[1] * bf_hi(uu.x); y[2] = acc[2] + Dv[2] * bf_lo(uu.y); y[3] = acc[3] + Dv[3] * bf_hi(uu.y);
#pragma unroll
                for (int r = 0; r < 4; ++r) y[r] = y[r] * sigmoidf_(1.5957691216057308f * (y[r] + 0.044715f * y[r] * y[r] * y[r]));
                u32x2 zw; zw.x = cvt_pk_bf16(y[0], y[1]); zw.y = cvt_pk_bf16(y[2], y[3]);
                *(u32x2*)(S.PROJw + m * PLD + 1536 + g * 16 + 4 * lq) = zw;
            }
            LDS_WAIT();
        }
    }
    if (!PASSB) { float* sp = (float*)S.Sloc + (size_t)((b * 16 + c) * 32 + g) * 64 + lane; sp[0] = hr; sp[262144] = hi; }
    if (PASSB && !sample && c == 15) { S.p_re[(size_t)(b * 32 + g) * 64 + lane] = hr; S.p_im[(size_t)(b * 32 + g) * 64 + lane] = hi; }
}

struct SguCtx { const bf16_t* PROJ; bf16_t* MIX; const float* ssqv; const float* gnorm; const bf16_t* Wm; const float* sgu_w; const float* sgu_b; float* s_v; };

__device__ __forceinline__ void sgu_unit(const SguCtx& S, LAS bf16_t* VT, int lane, int m0, int hd) {
    const int l15 = lane & 15, lq = lane >> 4;
#pragma unroll
    for (int jj = 0; jj < 2; ++jj) {
        const int j = lane + 64 * jj; const size_t m = (size_t)(m0 + j); const f32x4 q0 = *(const f32x4*)(S.ssqv + m * 4), q1 = *(const f32x4*)(S.ssqv + ((size_t)MT + m) * 4); const float rs = rstd_of(((q0[0] + q0[1]) + (q0[2] + q0[3])) + ((q1[0] + q1[1]) + (q1[2] + q1[3])), 1.0f / 512);
#pragma unroll
        for (int d8 = 0; d8 < 8; ++d8) {
            const u32x4 v = *(const u32x4*)(S.PROJ + m * PLD + 1024 + hd * 64 + 8 * d8);
            const f32x4 g0 = *(const f32x4*)(S.gnorm + hd * 64 + 8 * d8), g1 = *(const f32x4*)(S.gnorm + hd * 64 + 8 * d8 + 4);
            LAS bf16_t* p = VT + (8 * d8) * 136 + j;
            p[0 * 136] = f2bf(bf_lo(v.x) * rs * g0[0]); p[1 * 136] = f2bf(bf_hi(v.x) * rs * g0[1]); p[2 * 136] = f2bf(bf_lo(v.y) * rs * g0[2]); p[3 * 136] = f2bf(bf_hi(v.y) * rs * g0[3]);
            p[4 * 136] = f2bf(bf_lo(v.z) * rs * g1[0]); p[5 * 136] = f2bf(bf_hi(v.z) * rs * g1[1]); p[6 * 136] = f2bf(bf_lo(v.w) * rs * g1[2]); p[7 * 136] = f2bf(bf_hi(v.w) * rs * g1[3]);
        }
    }
    LDS_WAIT();
    for (int ib = 0; ib < 8; ++ib) {
        const int nks = (ib >> 1) + 1;
        bf16x8 Bw[4];
#pragma unroll
        for (int ks = 0; ks < 4; ++ks) if (ks < nks) Bw[ks] = *(const bf16x8*)(S.Wm + (size_t)((hd * 128 + 16 * ib + l15) * 128 + 32 * ks + 8 * lq));
        const int i = 16 * ib + l15; const size_t m = (size_t)(m0 + i); const float bias = S.sgu_b[hd * 128 + i];
#pragma unroll
        for (int db = 0; db < 4; ++db) {
            f32x4 acc = (f32x4){0.f, 0.f, 0.f, 0.f};
#pragma unroll
            for (int ks = 0; ks < 4; ++ks) if (ks < nks) {
                const bf16x8 Av = *(const LAS bf16x8*)(VT + (16 * db + l15) * 136 + 32 * ks + 8 * lq);
                acc = __builtin_amdgcn_mfma_f32_16x16x32_bf16(Av, Bw[ks], acc, 0, 0, 0);
            }
            const int col = hd * 64 + 16 * db + 4 * lq;
            const u32x2 uu = *(const u32x2*)(S.PROJ + m * PLD + 512 + col);
            u32x2 w; w.x = cvt_pk_bf16(bf_lo(uu.x) * (acc[0] + bias), bf_hi(uu.x) * (acc[1] + bias)); w.y = cvt_pk_bf16(bf_lo(uu.y) * (acc[2] + bias), bf_hi(uu.y) * (acc[3] + bias));
            *(u32x2*)(S.MIX + m * DM + 512 + col) = w;
        }
    }
    LDS_WAIT();
}

#define MAKE_SC S5Ctx SC{PROJ, PROJ, (const f32x2*)((const float*)(ws + WS_ATAB) + i * 2048), (const f32x2*)((const float*)(ws + WS_A128) + i * 2048), (const bf16_t*)(ws + WS_BBAR) + (size_t)i * 32 * 128 * 16, (const bf16_t*)(ws + WS_CTAB) + (size_t)i * 32 * 16 * 128, args.in[18] + i * 512, (f32x2*)(ws + WS_SLOC), (const f32x2*)(ws + WS_CAR), args.in[2] + (size_t)i * 128 * 2048, args.in[3] + (size_t)i * 128 * 2048, args.out + O_PRE + (size_t)i * 8 * 2048, args.out + O_PIM + (size_t)i * 8 * 2048, args.out + O_SRE + (size_t)i * 128 * 2048, args.out + O_SIM + (size_t)i * 128 * 2048};
#define MAKE_GC SguCtx GC{PROJ, MIX, ssqv + (size_t)i * MT * 8, args.in[21] + i * 512, (const bf16_t*)(ws + WS_WM) + (size_t)i * 8 * 128 * 128, args.in[22] + (size_t)i * 8 * 128 * 128, args.in[23] + i * 1024, args.out + O_SV + (size_t)i * 128 * 4 * 512};
#define RUN_GEMM(EPI) pg8::gemm_phase<EPI, true, pg8::StaticOrder>(lds, g, S, E)
__global__ void __launch_bounds__(512, 2) fwd_megakernel(Args args) {
    extern __shared__ __attribute__((aligned(16))) unsigned char lds_raw[];
    LAS unsigned char* lds = (LAS unsigned char*)lds_raw;
    cg::grid_group grid = cg::this_grid();
    const int G = gridDim.x, bx = blockIdx.x, NGW = G * 8, NGT = G * 512;
    const int lo = args.ph_lo, hi = args.ph_hi; int pidx = 0;
#define PH_BEGIN if (pidx >= lo && pidx < hi) { \
    const int tid = launder_v(threadIdx.x), lane = tid & 63, wave = __builtin_amdgcn_readfirstlane(tid >> 6); \
    const int gw = bx * 8 + wave, gt = bx * 512 + tid; (void)gw; (void)gt; (void)lane; \
    const size_t lz_ = launder_zero(); unsigned char* ws = args.ws + lz_; float* H = args.out + lz_; \
    float* ssq = (float*)(ws + WS_SSQ); float* ssqv = (float*)(ws + WS_SSQV); (void)ssqv; bf16_t* HB = (bf16_t*)(ws + WS_HB); bf16_t* PROJ = (bf16_t*)(ws + WS_PROJ); bf16_t* MIX = (bf16_t*)(ws + WS_MIX); bf16_t* ACT = (bf16_t*)(ws + WS_ACT); \
    (void)ssq; (void)HB; (void)PROJ; (void)MIX; (void)ACT; (void)H; \
    LAS unsigned char* wreg = lds + wave * WREG; (void)wreg;
#define PH_END } if (pidx >= lo && pidx + 1 < hi) { asm volatile("s_waitcnt vmcnt(0) lgkmcnt(0)" ::: "memory"); __builtin_amdgcn_fence(__ATOMIC_RELEASE, "agent"); asm volatile("s_waitcnt vmcnt(0)" ::: "memory"); \
    grid.sync(); __builtin_amdgcn_fence(__ATOMIC_ACQUIRE, "agent"); asm volatile("s_waitcnt vmcnt(0)" ::: "memory"); } ++pidx;

    PH_BEGIN
    {
        LAS float* scr = (LAS float*)wreg;
        for (int i = 0; i < 2; ++i) {
            const int Le = 2 * i, Lo = 2 * i + 1;
            xpose_mat(args.in[9] + (size_t)i * DM * 1536, 1536, DM, 1536, (bf16_t*)(ws + WS_W1E + i * 3 * MiB), DM, 0, args.in[6] + Le * DM, 0, scr, gw, NGW, lane);
            xpose_mat(args.in[10] + (size_t)i * DM * DM, DM, DM, DM, (bf16_t*)(ws + WS_WOE + i * 2 * MiB), DM, 0, nullptr, 0, scr, gw, NGW, lane);
            xpose_mat(args.in[19] + (size_t)i * 512 * 512, 512, 512, 512, (bf16_t*)(ws + WS_GLU + i * (MiB / 2)), 512, 0, nullptr, 0, scr, gw, NGW, lane);
            xpose_mat(args.in[24] + (size_t)i * DM * 2048, 2048, DM, 2048, (bf16_t*)(ws + WS_W1O + i * 4 * MiB), DM, 0, args.in[6] + Lo * DM, 0, scr, gw, NGW, lane);
            xpose_mat(args.in[25] + (size_t)i * DM * DM + (size_t)512 * DM, DM, 512, DM, (bf16_t*)(ws + WS_WOO + i * 2 * MiB), DM, 512, nullptr, 0, scr, gw, NGW, lane);
        }
        for (int L = 0; L < 4; ++L) {
            bf16_t* wgu = (bf16_t*)(ws + WS_WGU + L * 11 * MiB);
            xpose_mat(args.in[30] + (size_t)L * DM * FF, FF, DM, FF, wgu, DM, 0, args.in[7] + L * DM, 1, scr, gw, NGW, lane);
            xpose_mat(args.in[31] + (size_t)L * DM * FF, FF, DM, FF, wgu, DM, 0, args.in[7] + L * DM, 2, scr, gw, NGW, lane);
            xpose_mat(args.in[32] + (size_t)L * FF * DM, DM, FF, DM, (bf16_t*)(ws + WS_WD + L * (11 * MiB / 2)), FF, 0, nullptr, 0, scr, gw, NGW, lane);
        }
        for (int it = gw; it < 2 * 4 * 2 * 128; it += NGW) {
            const int i = it >> 10, g = (it >> 8) & 3, ch = (it >> 7) & 1, n0 = (it & 127) * 8, c = ch * 64 + lane;
            const float* pw = args.in[26] + (size_t)((i * 4 + g) * 128 + c) * 128; const float* sc = args.in[27] + i * 512 + g * 128;
            const float* wo = args.in[25] + (size_t)i * DM * DM + (size_t)(g * 128) * DM + n0;
            float s8[8];
#pragma unroll
            for (int e = 0; e < 8; ++e) s8[e] = 0.f;
            for (int d = 0; d < 128; d += 4) {
                const f32x4 p4 = *(const f32x4*)(pw + d);
#pragma unroll
                for (int dd = 0; dd < 4; ++dd) { const float ps = p4[dd] * sc[d + dd]; const f32x4 w0 = *(const f32x4*)(wo + (size_t)(d + dd) * DM), w1 = *(const f32x4*)(wo + (size_t)(d + dd) * DM + 4);
                    s8[0] += ps * w0[0]; s8[1] += ps * w0[1]; s8[2] += ps * w0[2]; s8[3] += ps * w0[3]; s8[4] += ps * w1[0]; s8[5] += ps * w1[1]; s8[6] += ps * w1[2]; s8[7] += ps * w1[3]; }
            }
            bf16_t* dst = (bf16_t*)(ws + WS_WOO + i * 2 * MiB) + (size_t)n0 * DM + g * 128 + c;
#pragma unroll
            for (int e = 0; e < 8; ++e) dst[(size_t)e * DM] = f2bf(s8[e]);
        }
        for (int it = gt; it < 2 * 32 * 64; it += NGT) {
            const int i = it >> 11, g = (it >> 6) & 31, n = it & 63;
            const float lr = args.in[11][it], li = args.in[12][it], dt = expf(args.in[13][i * 32 + g]);
            const double mag = (double)expf(lr * dt); double sn, cs; sincos_d((double)li * (double)dt, sn, cs);
            const double ar = mag * cs, ai = mag * sn, den = (double)lr * lr + (double)li * li;
            const float fr = (float)(((ar - 1.0) * lr + ai * li) / den), fi = (float)((ai * lr - (ar - 1.0) * li) / den);
            ((float*)(ws + WS_ATAB))[it] = (float)ar; ((float*)(ws + WS_ATAB))[4096 + it] = (float)ai;
            double pr = ar, pi = ai;
#pragma unroll
            for (int s = 0; s < 7; ++s) { const double t = pr * pr - pi * pi; pi = 2.0 * pr * pi; pr = t; }
            ((float*)(ws + WS_A128))[it] = (float)pr; ((float*)(ws + WS_A128))[4096 + it] = (float)pi;
            bf16_t* bb = (bf16_t*)(ws + WS_BBAR); bf16_t* ct = (bf16_t*)(ws + WS_CTAB);
#pragma unroll 4
            for (int p = 0; p < 16; ++p) {
                const float br = args.in[14][(size_t)it * 16 + p], bi = args.in[15][(size_t)it * 16 + p];
                bb[(size_t)((i * 32 + g) * 128 + n) * 16 + p] = f2bf(fr * br - fi * bi); bb[(size_t)((i * 32 + g) * 128 + 64 + n) * 16 + p] = f2bf(fr * bi + fi * br);
                const size_t ci = (size_t)((i * 32 + g) * 16 + p) * 64 + n;
                ct[(size_t)((i * 32 + g) * 16 + p) * 128 + n] = f2bf(args.in[16][ci]); ct[(size_t)((i * 32 + g) * 16 + p) * 128 + 64 + n] = f2bf(-args.in[17][ci]);
            }
        }
        for (int it = gt; it < 2 * 8 * 128 * 128; it += NGT) { const int r = (it >> 7) & 127, c = it & 127; ((bf16_t*)(ws + WS_WM))[it] = c <= r ? f2bf(args.in[22][it]) : (bf16_t)0; }
        for (int m = gw; m < MT; m += NGW) {
            const float* src = m < MP ? args.in[0] + (size_t)m * DM : args.in[1] + (size_t)(m - MP) * DM;
            float s = 0.f;
#pragma unroll
            for (int j = 0; j < 4; ++j) { const f32x4 v = ((const f32x4*)src)[lane + 64 * j]; s += (v[0] * v[0] + v[1] * v[1]) + (v[2] * v[2] + v[3] * v[3]);
                ((f32x4*)(H + (size_t)m * DM))[lane + 64 * j] = v; u32x2 w; w.x = cvt_pk_bf16(v[0], v[1]); w.y = cvt_pk_bf16(v[2], v[3]); ((u32x2*)(HB + (size_t)m * DM))[lane + 64 * j] = w; }
            s = wave_sum(s); if (lane < 16) ssq[((size_t)(lane >> 2) * MT + m) * 4 + (lane & 3)] = lane == 0 ? s : 0.f;
        }
    }
    PH_END

    for (int L = 0; L < DBG_LAYERS; ++L) {
        const int i = L >> 1; const bool even = (L & 1) == 0;
        PH_BEGIN
        {
            const int N = even ? 1536 : 2048;
            pg8::Gemm g{HB, (const bf16_t*)(ws + (even ? WS_W1E + i * 3 * MiB : WS_W1O + i * 4 * MiB)), MT, N, DM, DM, DM};
            pg8::StaticOrder S; S.init(MT, N, G, bx);
            pg8::EpiProj E{PROJ, PLD, ssq + (size_t)(2 * L) * MT * 16, even ? ssqv + (size_t)i * MT * 8 : nullptr, 1024};
            RUN_GEMM(pg8::EpiProj);
        }
        PH_END
        if (even) {
            PH_BEGIN
#if defined(DBG_NOMIX)
            { for (int it = gt; it < MT * 64; it += NGT) { const int m = it >> 6, c8 = it & 63; *(u32x4*)(MIX + (size_t)m * DM + 8 * c8) = *(const u32x4*)(PROJ + (size_t)m * PLD + 8 * c8); } }
#endif
            {
                MAKE_SC MAKE_GC
                for (int wu = gw; wu < 3840 + 1024; wu += NGW) {
                    if (wu < 3840) { const int g = wu & 31, bc = wu >> 5, b = bc / 15, c = bc % 15; s5_unit<false>(SC, (LAS float*)wreg, lane, b * SEQ + c * 128, g, false, b, c); }
                    else { const int su = wu - 3840, hd = su & 7, bc = su >> 3; sgu_unit(GC, (LAS bf16_t*)wreg, lane, bc * 128, hd); }
                }
                for (int it = gt; it < MSAMP * 64; it += NGT) {
                    const int sr = it >> 6, c8 = it & 63, col = 8 * c8, hd = col >> 6, b = sr >> 2, t = sr & 3;
                    float mix[8], vt[8];
#pragma unroll
                    for (int e = 0; e < 8; ++e) { mix[e] = 0.f; vt[e] = 0.f; }
                    const f32x4 g0 = *(const f32x4*)(GC.gnorm + col), g1 = *(const f32x4*)(GC.gnorm + col + 4);
                    for (int j = 0; j <= t; ++j) {
                        const size_t mj = (size_t)(MP + 4 * b + j); const f32x4 q0 = *(const f32x4*)(GC.ssqv + mj * 4), q1 = *(const f32x4*)(GC.ssqv + ((size_t)MT + mj) * 4); const float rs = rstd_of(((q0[0] + q0[1]) + (q0[2] + q0[3])) + ((q1[0] + q1[1]) + (q1[2] + q1[3])), 1.0f / 512);
                        const u32x4 v = *(const u32x4*)(PROJ + mj * PLD + 1024 + col);
                        float vn[8]; vn[0] = bf_lo(v.x) * rs * g0[0]; vn[1] = bf_hi(v.x) * rs * g0[1]; vn[2] = bf_lo(v.y) * rs * g0[2]; vn[3] = bf_hi(v.y) * rs * g0[3];
                        vn[4] = bf_lo(v.z) * rs * g1[0]; vn[5] = bf_hi(v.z) * rs * g1[1]; vn[6] = bf_lo(v.w) * rs * g1[2]; vn[7] = bf_hi(v.w) * rs * g1[3];
                        const float w = GC.sgu_w[(size_t)(hd * 128 + t) * 128 + j];
#pragma unroll
                        for (int e = 0; e < 8; ++e) { mix[e] += w * vn[e]; vt[e] = vn[e]; }
                    }
                    const float bias = GC.sgu_b[hd * 128 + t]; const size_t m = (size_t)(MP + sr);
                    const u32x4 uu = *(const u32x4*)(PROJ + m * PLD + 512 + col);
                    u32x4 w; w.x = cvt_pk_bf16(bf_lo(uu.x) * (mix[0] + bias), bf_hi(uu.x) * (mix[1] + bias)); w.y = cvt_pk_bf16(bf_lo(uu.y) * (mix[2] + bias), bf_hi(uu.y) * (mix[3] + bias));
                    w.z = cvt_pk_bf16(bf_lo(uu.z) * (mix[4] + bias), bf_hi(uu.z) * (mix[5] + bias)); w.w = cvt_pk_bf16(bf_lo(uu.w) * (mix[6] + bias), bf_hi(uu.w) * (mix[7] + bias));
                    *(u32x4*)(MIX + m * DM + 512 + col) = w;
                    float* sv = GC.s_v + (size_t)sr * 512 + col;
                    *(f32x4*)sv = (f32x4){vt[0], vt[1], vt[2], vt[3]}; *(f32x4*)(sv + 4) = (f32x4){vt[4], vt[5], vt[6], vt[7]};
                }
            }
            PH_END
            PH_BEGIN
            {
                const float* a128t = (const float*)(ws + WS_A128) + i * 2048; const float* sl = (const float*)(ws + WS_SLOC); float* car = (float*)(ws + WS_CAR);
                for (int it = gt; it < 8 * 32 * 64; it += NGT) {
                    const int b = it >> 11, gn = it & 2047; const float a128x = a128t[gn], a128y = a128t[4096 + gn]; float hr = 0.f, hi = 0.f;
                    for (int c = 0; c < 16; ++c) { car[(size_t)(b * 16 + c) * 2048 + gn] = hr; car[262144 + (size_t)(b * 16 + c) * 2048 + gn] = hi;
                        if (c < 15) { const float svx = sl[(size_t)(b * 16 + c) * 2048 + gn], svy = sl[262144 + (size_t)(b * 16 + c) * 2048 + gn]; const float nr = a128x * hr - a128y * hi + svx; hi = a128x * hi + a128y * hr + svy; hr = nr; } }
                }
            }
            PH_END
            PH_BEGIN
            {
                MAKE_SC
                for (int wu = gw; wu < 4096 + 128; wu += NGW) {
                    if (wu < 4096) { const int g = wu & 31, bc = wu >> 5, b = bc >> 4, c = bc & 15; s5_unit<true>(SC, (LAS float*)wreg, lane, b * SEQ + c * 128, g, false, b, c); }
                    else { const int su = wu - 4096, g = su & 31, sbk = su >> 5; s5_unit<true>(SC, (LAS float*)wreg, lane, MP + 128 * sbk, g, true, 32 * sbk, 0); }
                }
            }
            PH_END
            PH_BEGIN
#if defined(DBG_NOMIX)
            if (0)
#endif
            {
                pg8::Gemm g{PROJ + 1536, (const bf16_t*)(ws + WS_GLU + i * (MiB / 2)), MT, 512, 512, PLD, 512};
                pg8::StaticOrder S; S.init(MT, 512, G, bx);
                pg8::EpiGlu E{MIX, DM, PROJ + 1536, PLD, args.in[20] + i * 512};
                RUN_GEMM(pg8::EpiGlu);
            }
            PH_END
        } else {
            PH_BEGIN
#if defined(DBG_NOMIX_ODD)
            { for (int it = gt; it < MT * 128; it += NGT) { const int m = it >> 7, c8 = it & 127; *(u32x4*)(MIX + (size_t)m * DM + 8 * c8) = *(const u32x4*)(PROJ + (size_t)m * PLD + 8 * c8); } }
            if (0)
#endif
            {
                const float* spool = args.in[4] + (size_t)i * 128 * 15 * 512; const float* sconv = args.in[5] + (size_t)i * 128 * 2 * 512;
                const float* cw = args.in[28] + i * 3 * 512; const float* cb = args.in[29] + i * 512;
                float* ppool = args.out + O_PPOOL + (size_t)i * 8 * 15 * 512; float* pconv = args.out + O_PCONV + (size_t)i * 8 * 2 * 512;
                float* opool = args.out + O_SPOOL + (size_t)i * 128 * 15 * 512; float* oconv = args.out + O_SCONV + (size_t)i * 128 * 2 * 512;
                for (int it = gt; it < MT * 128; it += NGT) {
                    const int m = it >> 7, c8 = it & 127, col = 8 * c8; const bool samp = m >= MP;
                    const int b = samp ? (m - MP) >> 2 : m >> 11, t = samp ? (m - MP) & 3 : m & 2047;
                    if (col < 512) {
                        const int w = 2 << (col >> 7);
                        float s[8], x0[8];
#pragma unroll
                        for (int e = 0; e < 8; ++e) s[e] = 0.f;
                        int n = 0;
                        for (int k = 0; k < w; ++k) {
                            const int p = t - k;
                            if (p >= 0) { const u32x4 v = *(const u32x4*)(PROJ + (size_t)(m - k) * PLD + col);
                                float f[8]; f[0] = bf_lo(v.x); f[1] = bf_hi(v.x); f[2] = bf_lo(v.y); f[3] = bf_hi(v.y); f[4] = bf_lo(v.z); f[5] = bf_hi(v.z); f[6] = bf_lo(v.w); f[7] = bf_hi(v.w);
#pragma unroll
                                for (int e = 0; e < 8; ++e) { s[e] += f[e]; if (k == 0) x0[e] = f[e]; }
                                ++n; }
                            else if (samp) { const float* q = spool + (size_t)(b * 15 + 15 + p) * 512 + col; const f32x4 a0 = *(const f32x4*)q, a1 = *(const f32x4*)(q + 4);
                                s[0] += a0[0]; s[1] += a0[1]; s[2] += a0[2]; s[3] += a0[3]; s[4] += a1[0]; s[5] += a1[1]; s[6] += a1[2]; s[7] += a1[3]; ++n; }
                        }
                        const float inv = 1.0f / (float)n;
                        u32x4 o; o.x = cvt_pk_bf16(s[0] * inv - x0[0], s[1] * inv - x0[1]); o.y = cvt_pk_bf16(s[2] * inv - x0[2], s[3] * inv - x0[3]);
                        o.z = cvt_pk_bf16(s[4] * inv - x0[4], s[5] * inv - x0[5]); o.w = cvt_pk_bf16(s[6] * inv - x0[6], s[7] * inv - x0[7]);
                        *(u32x4*)(MIX + (size_t)m * DM + col) = o;
                        if (!samp) { if (t >= SEQ - 15) { float* q = ppool + (size_t)(b * 15 + t - (SEQ - 15)) * 512 + col; *(f32x4*)q = (f32x4){x0[0], x0[1], x0[2], x0[3]}; *(f32x4*)(q + 4) = (f32x4){x0[4], x0[5], x0[6], x0[7]}; } }
                        else { float* q = opool + (size_t)(b * 15 + 11 + t) * 512 + col; *(f32x4*)q = (f32x4){x0[0], x0[1], x0[2], x0[3]}; *(f32x4*)(q + 4) = (f32x4){x0[4], x0[5], x0[6], x0[7]};
                            if (t == 0) for (int r = 0; r < 11; ++r) { const float* sp = spool + (size_t)(b * 15 + r + 4) * 512 + col; float* dp = opool + (size_t)(b * 15 + r) * 512 + col;
                                *(f32x4*)dp = *(const f32x4*)sp; *(f32x4*)(dp + 4) = *(const f32x4*)(sp + 4); } }
                    } else {
                        const int d = col - 512;
                        float z[3][8];
#pragma unroll
                        for (int k = 0; k < 3; ++k) {
                            const int p = t - k;
                            if (p >= 0) { const u32x4 xv = *(const u32x4*)(PROJ + (size_t)(m - k) * PLD + 512 + d), cv = *(const u32x4*)(PROJ + (size_t)(m - k) * PLD + 1536 + d);
                                z[k][0] = bf_lo(xv.x) * bf_lo(cv.x); z[k][1] = bf_hi(xv.x) * bf_hi(cv.x); z[k][2] = bf_lo(xv.y) * bf_lo(cv.y); z[k][3] = bf_hi(xv.y) * bf_hi(cv.y);
                                z[k][4] = bf_lo(xv.z) * bf_lo(cv.z); z[k][5] = bf_hi(xv.z) * bf_hi(cv.z); z[k][6] = bf_lo(xv.w) * bf_lo(cv.w); z[k][7] = bf_hi(xv.w) * bf_hi(cv.w); }
                            else if (samp) { const float* q = sconv + (size_t)(b * 2 + 2 + p) * 512 + d; const f32x4 a0 = *(const f32x4*)q, a1 = *(const f32x4*)(q + 4);
                                z[k][0] = a0[0]; z[k][1] = a0[1]; z[k][2] = a0[2]; z[k][3] = a0[3]; z[k][4] = a1[0]; z[k][5] = a1[1]; z[k][6] = a1[2]; z[k][7] = a1[3]; }
                            else {
#pragma unroll
                                for (int e = 0; e < 8; ++e) z[k][e] = 0.f; }
                        }
                        const u32x4 bg = *(const u32x4*)(PROJ + (size_t)m * PLD + 1024 + d);
                        float bgf[8]; bgf[0] = bf_lo(bg.x); bgf[1] = bf_hi(bg.x); bgf[2] = bf_lo(bg.y); bgf[3] = bf_hi(bg.y); bgf[4] = bf_lo(bg.z); bgf[5] = bf_hi(bg.z); bgf[6] = bf_lo(bg.w); bgf[7] = bf_hi(bg.w);
                        float y[8];
#pragma unroll
                        for (int e = 0; e < 8; ++e) y[e] = bgf[e] * (cb[d + e] + z[2][e] * cw[d + e] + z[1][e] * cw[512 + d + e] + z[0][e] * cw[1024 + d + e]);
                        u32x4 o; o.x = cvt_pk_bf16(y[0], y[1]); o.y = cvt_pk_bf16(y[2], y[3]); o.z = cvt_pk_bf16(y[4], y[5]); o.w = cvt_pk_bf16(y[6], y[7]);
                        *(u32x4*)(MIX + (size_t)m * DM + col) = o;
                        float* q = nullptr;
                        if (!samp) { if (t >= SEQ - 2) q = pconv + (size_t)(b * 2 + t - (SEQ - 2)) * 512 + d; } else { if (t >= 2) q = oconv + (size_t)(b * 2 + t - 2) * 512 + d; }
                        if (q) { *(f32x4*)q = (f32x4){z[0][0], z[0][1], z[0][2], z[0][3]}; *(f32x4*)(q + 4) = (f32x4){z[0][4], z[0][5], z[0][6], z[0][7]}; }
                    }
                }
            }
            PH_END
        }
        PH_BEGIN
        {
            pg8::Gemm g{MIX, (const bf16_t*)(ws + (even ? WS_WOE : WS_WOO) + i * 2 * MiB), MT, DM, DM, DM, DM};
            pg8::StaticOrder S; S.init(MT, DM, G, bx);
            pg8::EpiResid E{H, HB, ssq + (size_t)(2 * L + 1) * MT * 16};
            RUN_GEMM(pg8::EpiResid);
        }
        PH_END
        PH_BEGIN
        {
            pg8::Gemm g{HB, (const bf16_t*)(ws + WS_WGU + L * 11 * MiB), MT, NGU, DM, DM, DM};
            pg8::StaticOrder S; S.init(MT, NGU, G, bx);
            pg8::EpiSwiglu E{ACT, ssq + (size_t)(2 * L + 1) * MT * 16};
            RUN_GEMM(pg8::EpiSwiglu);
        }
        PH_END
        PH_BEGIN
        {
            pg8::Gemm g{ACT, (const bf16_t*)(ws + WS_WD + L * (11 * MiB / 2)), MT, DM, FF, FF, FF};
            pg8::StaticOrder S; S.init(MT, DM, G, bx);
            pg8::EpiResid E{H, HB, ssq + (size_t)(2 * L + 2) * MT * 16};
            RUN_GEMM(pg8::EpiResid);
        }
        PH_END
    }
    PH_BEGIN
    {
        const float* sq = ssq + (size_t)8 * MT * 16; const f32x4* gf = (const f32x4*)args.in[8];
        for (int it = gt; it < MT * 256; it += NGT) { const int m = it >> 8, c4 = it & 255; const f32x4* q = (const f32x4*)sq + m; const f32x4 qa = q[0], qb = q[(size_t)MT], qc = q[(size_t)2 * MT], qd = q[(size_t)3 * MT];
            const float rs = rstd_of((((qa[0] + qa[1]) + (qa[2] + qa[3])) + ((qb[0] + qb[1]) + (qb[2] + qb[3]))) + (((qc[0] + qc[1]) + (qc[2] + qc[3])) + ((qd[0] + qd[1]) + (qd[2] + qd[3]))), 1.0f / DM);
            f32x4 v = ((f32x4*)H)[it]; const f32x4 gg = gf[c4]; v = v * rs * gg; ((f32x4*)H)[it] = v; }
    }
    PH_END
#if defined(DBG_MASK)
    PH_BEGIN
    {
        float* o = args.out; (void)ws;
        for (size_t it = (size_t)gt; it < O_END; it += NGT) {
            int cls;
            if (it < (size_t)MP * DM) cls = 0; else if (it < O_PRE) cls = 1; else if (it < O_PPOOL) cls = 2; else if (it < O_SRE) cls = 3; else if (it < O_SV) cls = 2; else if (it < O_SPOOL) cls = 4; else cls = 3;
            if ((DBG_MASK >> cls) & 1) o[it] = 0.f;
        }
    }
    PH_END
#endif
#undef PH_BEGIN
#undef PH_END
#if defined(DBG_STOP)
    if (lo == 99) {
        const int tid = threadIdx.x; unsigned char* ws = args.ws; float* o = args.out + O_SPOOL;
        const int NEL = (int)(O_END - O_SPOOL);
        for (int it = bx * 512 + tid; it < NEL; it += NGT) {
            float v;
            if (DBG_SRC == 0) { const int r = it >> 10, c = it & 1023; const int row = MP + (r % MSAMP); v = bf1(f2bf(args.out[(size_t)row * DM + c])); }
            else if (DBG_SRC == 1) { const int r = it >> 11, c = it & 2047; const int row = MP + (r % MSAMP); v = bf1(((const bf16_t*)(ws + WS_PROJ))[(size_t)row * PLD + c]); }
            else if (DBG_SRC == 2) { const int r = it >> 10, c = it & 1023; const int row = MP + (r % MSAMP); v = bf1(((const bf16_t*)(ws + WS_MIX))[(size_t)row * DM + c]); }
            else if (DBG_SRC == 5) { const int r = (it >> 11) % MSAMP, c = it & 2047; if (it >= MSAMP * 2048) { o[it] = 0.f; continue; }
                const bf16_t* a = (const bf16_t*)(ws + WS_HB) + (size_t)(MP + r) * DM; const bf16_t* w = (const bf16_t*)(ws + WS_W1O + 4 * MiB) + (size_t)c * DM; float acc = 0.f;
                for (int k = 0; k < DM; ++k) acc += bf1(a[k]) * bf1(w[k]);
                v = bf1(f2bf(acc)); }
            else if (DBG_SRC == 4) { const int r = it >> 10, c = it & 1023; const int row = MP + (r % MSAMP); v = bf1(((const bf16_t*)(ws + WS_HB))[(size_t)row * DM + c]); }
            else { const int r = it / FF, c = it % FF; const int row = MP + (r % MSAMP); v = bf1(((const bf16_t*)(ws + WS_ACT))[(size_t)row * FF + c]); }
            o[it] = v;
        }
    }
#endif
}

#if defined(DBG_MASK)
constexpr int N_PHASES = 1 + 2 * 8 + 2 * 5 + 2;
#else
constexpr int N_PHASES = 1 + 2 * 8 + 2 * 5 + 1;
#endif

extern "C" void kernel_launch(void* const* d_in, const int* in_sizes, int n_in, void* d_out, int out_size, void* d_ws, size_t ws_size, hipStream_t stream) {
    static int grid = 0;
    if (grid == 0) {
        if (n_in != 33 || out_size != (int)O_END || ws_size < WS_END) { fprintf(stderr, "kernel_launch: unexpected shapes n_in %d out %d ws %zu\n", n_in, out_size, ws_size); grid = -1; return; }
        int dev = 0, cus = 0, per_cu = 0;
        hipGetDevice(&dev); hipDeviceGetAttribute(&cus, hipDeviceAttributeMultiprocessorCount, dev);
        hipFuncSetAttribute((const void*)fwd_megakernel, hipFuncAttributeMaxDynamicSharedMemorySize, LDS_BYTES);
        hipOccupancyMaxActiveBlocksPerMultiprocessor(&per_cu, (const void*)fwd_megakernel, 512, LDS_BYTES);
        if (per_cu < 1) { fprintf(stderr, "kernel_launch: occupancy query says %d blocks per CU\n", per_cu); per_cu = 1; }
        (void)hipGetLastError();
        grid = cus;
    }
    if (grid < 0) return;
#if defined(DBG_FILLWS)
    (void)hipMemsetAsync((char*)d_ws + DBG_F0 * MiB, 0, (size_t)(DBG_F1 - DBG_F0) * MiB, stream); (void)hipMemsetAsync(d_out, 0, O_END * 4, stream);
#endif
#if defined(DBG_TINYSET)
    (void)hipMemsetAsync((char*)d_ws + 255 * MiB, 0, 256, stream); (void)hipMemsetAsync((char*)d_ws + 255 * MiB + 4096, 0, 256, stream);
#endif
    Args a{};
    for (int i = 0; i < 33; ++i) a.in[i] = (const float*)d_in[i];
    a.out = (float*)d_out; a.ws = (unsigned char*)d_ws;
#if MK_PER_PHASE
#if defined(DBG_STOP)
    for (int p = 0; p < DBG_STOP; ++p) { a.ph_lo = p; a.ph_hi = p + 1; hipLaunchKernelGGL(fwd_megakernel, dim3(grid), dim3(512), LDS_BYTES, stream, a); }
    a.ph_lo = 99; a.ph_hi = 100; hipLaunchKernelGGL(fwd_megakernel, dim3(grid), dim3(512), LDS_BYTES, stream, a);
#else
    for (int p = 0; p < N_PHASES; ++p) { a.ph_lo = p; a.ph_hi = p + 1; hipLaunchKernelGGL(fwd_megakernel, dim3(grid), dim3(512), LDS_BYTES, stream, a); }
#endif
#else
    a.ph_lo = 0; a.ph_hi = N_PHASES;
    void* kargs[] = {&a};
    hipError_t e = hipLaunchCooperativeKernel((const void*)fwd_megakernel, dim3(grid), dim3(512), kargs, LDS_BYTES, stream);
    if (e != hipSuccess) fprintf(stderr, "cooperative launch failed: %s (grid %d)\n", hipGetErrorString(e), grid);
#endif
}
```

```cpp
#include <hip/hip_runtime.h>
#include <hip/hip_cooperative_groups.h>
#include <cstdio>
#include <cstdint>
namespace cg = cooperative_groups;

#ifndef MK_PER_PHASE
#define MK_PER_PHASE 0
#endif

#ifndef DBG_LAYERS
#define DBG_LAYERS 4
#endif
#ifndef DBG_SKIP
#define DBG_SKIP 0
#endif
#define LAS __attribute__((address_space(3)))
typedef unsigned short bf16_t;
typedef short bf16x8 __attribute__((ext_vector_type(8)));
typedef float f32x2 __attribute__((ext_vector_type(2)));
typedef float f32x4 __attribute__((ext_vector_type(4)));
typedef float f32x16 __attribute__((ext_vector_type(16)));
typedef unsigned u32x4 __attribute__((ext_vector_type(4)));
typedef unsigned u32x2 __attribute__((ext_vector_type(2)));

constexpr int DM = 1024, MP = 16384, MSAMP = 512, MT = MP + MSAMP, FF = 2816, NGU = 2 * FF, SEQ = 2048;
constexpr float EPS = 1e-6f;
constexpr int PLD = 2048;
constexpr size_t O_Y = 0, O_PRE = 17301504, O_PIM = 17334272, O_PPOOL = 17367040, O_PCONV = 17489920, O_SRE = 17506304, O_SIM = 18030592,
                 O_SV = 18554880, O_SPOOL = 19079168, O_SCONV = 21045248, O_END = 21307392;
constexpr size_t MiB = 1u << 20;
constexpr size_t WS_SSQ = 226 * MiB, WS_SSQV = 237 * MiB;
constexpr size_t WS_ATAB = 1 * MiB, WS_A128 = WS_ATAB + 32768, WS_BBAR = WS_ATAB + 65536, WS_CTAB = WS_BBAR + 262144, WS_WM = WS_CTAB + 262144;
constexpr size_t WS_SLOC = 3 * MiB;
constexpr size_t WS_W1E = 5 * MiB, WS_WOE = 11 * MiB, WS_GLU = 15 * MiB, WS_W1O = 16 * MiB, WS_WOO = 24 * MiB, WS_WGU = 28 * MiB, WS_WD = 72 * MiB;
constexpr size_t WS_HB = 94 * MiB, WS_PROJ = 127 * MiB, WS_MIX = 193 * MiB, WS_ACT = 127 * MiB, WS_ACT_END = 226 * MiB, WS_CAR = 239 * MiB, WS_BAR = 0, WS_END = 241 * MiB;
static_assert(WS_WM + 524288 <= WS_SLOC && WS_SSQ + 9 * (size_t)MT * 64 <= WS_SSQV && WS_SSQV + 2 * (size_t)MT * 32 <= 239 * MiB, "ws map");
static_assert(WS_ACT + (size_t)MT * FF * 2 <= WS_ACT_END, "act overlay");

constexpr int LDS_BYTES = 147456;
constexpr int WREG = 17408;

typedef __bf16 bf16x2_t __attribute__((ext_vector_type(2)));
__device__ __forceinline__ unsigned cvt_pk_bf16(float lo, float hi) { const f32x2 v = {lo, hi}; const bf16x2_t b = __builtin_convertvector(v, bf16x2_t); return __builtin_bit_cast(unsigned, b); }
__device__ __forceinline__ float bf_lo(unsigned w) { return __uint_as_float(w << 16); }
__device__ __forceinline__ float bf_hi(unsigned w) { return __uint_as_float(w & 0xffff0000u); }
__device__ __forceinline__ float bf1(bf16_t b) { return __uint_as_float((unsigned)b << 16); }
__device__ __forceinline__ bf16_t f2bf(float f) { return (bf16_t)(cvt_pk_bf16(f, 0.f) & 0xffffu); }
__device__ __forceinline__ float rstd_of(float ssq, float invn) { return rsqrtf(ssq * invn + EPS); }
__device__ __forceinline__ float sigmoidf_(float x) { return __builtin_amdgcn_rcpf(1.0f + __expf(-x)); }
#define LDS_WAIT() asm volatile("s_waitcnt lgkmcnt(0)" ::: "memory")
__device__ __forceinline__ float row_ssq16(const float* part, int row, int fq) { const f32x4 p = *(const f32x4*)(part + ((size_t)fq * MT + row) * 4);     float s = (p[0] + p[1]) + (p[2] + p[3]); s += __shfl_xor(s, 16); s += __shfl_xor(s, 32); return s; }
__device__ __forceinline__ int launder_v(int x) { asm volatile("" : "+v"(x)); return x; }
__device__ __forceinline__ size_t launder_zero() { size_t z = 0; asm volatile("" : "+s"(z)); return z; }

namespace pg8 {
constexpr int BM = 256, BK = 64, HALF = 128, HTB = HALF * BK * 2, STAGE_BYTES = 8 * HTB, NXCD = 8, WGM = 8;
__host__ __device__ __forceinline__ int lds_byte(int r, int c) { const int st = (r >> 4) * 2 + (c >> 5), rr = r & 15, cc = c & 31, ob = rr * 64 + cc * 2; return st * 1024 + (ob ^ (((ob >> 9) & 1) << 5)); }
__host__ __device__ __forceinline__ void stage_rc(int b, int& R, int& C) { const int st = b / 1024, sb = b % 1024, swz = sb ^ (((sb >> 9) & 1) << 5); R = (st >> 1) * 16 + swz / 64; C = (st & 1) * 32 + (swz % 64) / 2; }
__host__ __device__ __forceinline__ int perm32(int rho) { const int n = rho >> 4, i = rho & 15; return 8 * (i >> 2) + 4 * n + (i & 3); }
struct Unit { int pm, pn; };
struct Gemm { const bf16_t* A; const bf16_t* Bt; int M, N, K, lda, ldb; };
struct StaticOrder {
    int nM, nN, nwg, G, c;
    __device__ void init(int M, int N, int G_, int c_) { nM = M / BM; nN = N / BM; nwg = nM * nN; G = G_; c = c_; }
    __device__ bool next(int i, Unit& u) const {
        const long L = (long)i * G + c; if (L >= nwg) return false;
        int wgid = (int)L; { const int q = nwg / NXCD, r = nwg % NXCD, xcd = wgid % NXCD, off = wgid / NXCD; wgid = (xcd < r ? xcd * (q + 1) : r * (q + 1) + (xcd - r) * q) + off; }
        const int nig = WGM * nN, gid = wgid / nig, fm = gid * WGM, gsz = (nM - fm) < WGM ? (nM - fm) : WGM;
        u.pm = fm + ((wgid % nig) % gsz); u.pn = (wgid % nig) / gsz; return true;
    }
};

struct EpiProj {
    bf16_t* O; int ldc; const float* ssq_in; float* ssq_v; int vcol0;
    __device__ __forceinline__ void operator()(const f32x4 (&acc)[2][2][4][2], const Unit& u, int wr, int wc, int fr, int fq) const {
        const int row0 = u.pm * BM + wr * 64 + fr, col0 = u.pn * BM + wc * 32 + 8 * fq;
        const bool dov = (ssq_v != nullptr) && (u.pn * BM >= vcol0);
#pragma unroll
        for (int ai = 0; ai < 2; ++ai)
#pragma unroll
            for (int m = 0; m < 4; ++m) {
                const int row = row0 + ai * HALF + m * 16;
#if defined(DBG_NORS)
                const float rs = 1.0f;
#else
                const float rs = rstd_of(row_ssq16(ssq_in, row, fq), 1.0f / DM);
#endif
                float sq = 0.f;
#pragma unroll
                for (int bj = 0; bj < 2; ++bj) { const f32x4 v0 = acc[ai][bj][m][0] * rs, v1 = acc[ai][bj][m][1] * rs;
                    u32x4 w; w.x = cvt_pk_bf16(v0[0], v0[1]); w.y = cvt_pk_bf16(v0[2], v0[3]); w.z = cvt_pk_bf16(v1[0], v1[1]); w.w = cvt_pk_bf16(v1[2], v1[3]);
                    *(u32x4*)(O + (size_t)row * ldc + col0 + bj * HALF) = w;
                    sq += (v0[0] * v0[0] + v0[1] * v0[1]) + (v0[2] * v0[2] + v0[3] * v0[3]) + (v1[0] * v1[0] + v1[1] * v1[1]) + (v1[2] * v1[2] + v1[3] * v1[3]); }
                if (dov) { sq += __shfl_xor(sq, 16); sq += __shfl_xor(sq, 32); if (fq == 0) ssq_v[((size_t)(u.pn - vcol0 / BM) * MT + row) * 4 + wc] = sq; }
            }
    }
};
struct EpiGlu {
    bf16_t* O; int ldc; const bf16_t* Z; int ldz; const float* bias;
    __device__ __forceinline__ void operator()(const f32x4 (&acc)[2][2][4][2], const Unit& u, int wr, int wc, int fr, int fq) const {
        const int row0 = u.pm * BM + wr * 64 + fr, col0 = u.pn * BM + wc * 32 + 8 * fq;
        f32x4 bv[2][2];
#pragma unroll
        for (int bj = 0; bj < 2; ++bj)
#pragma unroll
            for (int n = 0; n < 2; ++n) bv[bj][n] = *(const f32x4*)(bias + col0 + bj * HALF + 4 * n);
#pragma unroll
        for (int ai = 0; ai < 2; ++ai)
#pragma unroll
            for (int m = 0; m < 4; ++m) {
                const int row = row0 + ai * HALF + m * 16;
#pragma unroll
                for (int bj = 0; bj < 2; ++bj) { const u32x4 z = *(const u32x4*)(Z + (size_t)row * ldz + col0 + bj * HALF);
                    const f32x4 g0 = acc[ai][bj][m][0] + bv[bj][0], g1 = acc[ai][bj][m][1] + bv[bj][1];
                    u32x4 w;
                    w.x = cvt_pk_bf16(bf_lo(z.x) * sigmoidf_(g0[0]), bf_hi(z.x) * sigmoidf_(g0[1])); w.y = cvt_pk_bf16(bf_lo(z.y) * sigmoidf_(g0[2]), bf_hi(z.y) * sigmoidf_(g0[3]));
                    w.z = cvt_pk_bf16(bf_lo(z.z) * sigmoidf_(g1[0]), bf_hi(z.z) * sigmoidf_(g1[1])); w.w = cvt_pk_bf16(bf_lo(z.w) * sigmoidf_(g1[2]), bf_hi(z.w) * sigmoidf_(g1[3]));
                    *(u32x4*)(O + (size_t)row * ldc + col0 + bj * HALF) = w; }
            }
    }
};
struct EpiResid {
    float* H; bf16_t* HB; float* ssq_out; const float* xp; const float* xs;
    __device__ __forceinline__ void operator()(const f32x4 (&acc)[2][2][4][2], const Unit& u, int wr, int wc, int fr, int fq) const {
        const int row0 = u.pm * BM + wr * 64 + fr, col0 = u.pn * BM + wc * 32 + 8 * fq;
#pragma unroll
        for (int ai = 0; ai < 2; ++ai)
#pragma unroll
            for (int m = 0; m < 4; ++m) {
                const int row = row0 + ai * HALF + m * 16; float sq = 0.f;
#pragma unroll
                for (int bj = 0; bj < 2; ++bj) { float* hp = H + (size_t)row * DM + col0 + bj * HALF;
                    const float* bp = xp ? (row < MP ? xp + (size_t)row * DM : xs + (size_t)(row - MP) * DM) + col0 + bj * HALF : hp;
                    const f32x4 v0 = *(const f32x4*)bp + acc[ai][bj][m][0], v1 = *(const f32x4*)(bp + 4) + acc[ai][bj][m][1];
                    *(f32x4*)hp = v0; *(f32x4*)(hp + 4) = v1;
                    u32x4 w; w.x = cvt_pk_bf16(v0[0], v0[1]); w.y = cvt_pk_bf16(v0[2], v0[3]); w.z = cvt_pk_bf16(v1[0], v1[1]); w.w = cvt_pk_bf16(v1[2], v1[3]);
                    *(u32x4*)(HB + (size_t)row * DM + col0 + bj * HALF) = w;
                    sq += (v0[0] * v0[0] + v0[1] * v0[1]) + (v0[2] * v0[2] + v0[3] * v0[3]) + (v1[0] * v1[0] + v1[1] * v1[1]) + (v1[2] * v1[2] + v1[3] * v1[3]); }
                sq += __shfl_xor(sq, 16); sq += __shfl_xor(sq, 32); if (fq == 0) ssq_out[((size_t)u.pn * MT + row) * 4 + wc] = sq;
                if (m & 1) asm volatile("" ::: "memory");
            }
    }
};
struct EpiSwiglu {
    bf16_t* O; const float* ssq_in;
    __device__ __forceinline__ void operator()(const f32x4 (&acc)[2][2][4][2], const Unit& u, int wr, int wc, int fr, int fq) const {
        const int row0 = u.pm * BM + wr * 64 + fr, col0 = u.pn * HALF + wc * 32 + 8 * fq;
#pragma unroll
        for (int ai = 0; ai < 2; ++ai)
#pragma unroll
            for (int m = 0; m < 4; ++m) {
                const int row = row0 + ai * HALF + m * 16; const float rs = rstd_of(row_ssq16(ssq_in, row, fq), 1.0f / DM);
                const f32x4 g0 = acc[ai][0][m][0] * rs, g1 = acc[ai][0][m][1] * rs, u0 = acc[ai][1][m][0] * rs, u1 = acc[ai][1][m][1] * rs;
                u32x4 w;
                w.x = cvt_pk_bf16(g0[0] * sigmoidf_(g0[0]) * u0[0], g0[1] * sigmoidf_(g0[1]) * u0[1]); w.y = cvt_pk_bf16(g0[2] * sigmoidf_(g0[2]) * u0[2], g0[3] * sigmoidf_(g0[3]) * u0[3]);
                w.z = cvt_pk_bf16(g1[0] * sigmoidf_(g1[0]) * u1[0], g1[1] * sigmoidf_(g1[1]) * u1[1]); w.w = cvt_pk_bf16(g1[2] * sigmoidf_(g1[2]) * u1[2], g1[3] * sigmoidf_(g1[3]) * u1[3]);
                *(u32x4*)(O + (size_t)row * FF + col0) = w;
            }
    }
};

struct OneUnit { Unit u; __device__ bool next(int i, Unit& o) const { if (i != 0) return false; o = u; return true; } };
template <class Epi, bool ALIGN_EPI = true, class Sched = StaticOrder>
__device__ __forceinline__ void gemm_phase(LAS unsigned char* lds, const Gemm g, const Sched& S, const Epi& E) {
    const int tid = launder_v(threadIdx.x), wid = __builtin_amdgcn_readfirstlane(tid >> 6), lane = tid & 63, wr = wid >> 2, wc = wid & 3, fr = lane & 15, fq = lane >> 4;
    const int K = g.K, nt = K / BK;
    unsigned voffA[2], voffB[2];
#pragma unroll
    for (int i = 0; i < 2; ++i) { int R, C; stage_rc(tid * 16 + i * 8192, R, C); const int Rb = (R & ~31) + perm32(R & 31);
        voffA[i] = (unsigned)(R * g.lda + C) * 2u; voffB[i] = (unsigned)(Rb * g.ldb + C) * 2u; }
    const size_t kstep = (size_t)(BK * 2);
    const size_t hstepA = (size_t)HALF * g.lda * 2, hstepB = (size_t)HALF * g.ldb * 2;
    const size_t tstepA = 2 * hstepA, tstepB = 2 * hstepB;
    const unsigned ldsw = (unsigned)wid * 1024u;
    const int aoff = lds_byte(wr * 64 + fr, fq * 8), boff = lds_byte(wc * 32 + fr, fq * 8);
#define PG8_SA(b, h) (((b) * 2 + (h)) * HTB)
#define PG8_SB(b, h) ((4 + (b) * 2 + (h)) * HTB)
#define PG8_STAGE(bufoff, gbase, voff) do { _Pragma("unroll") for (int _i = 0; _i < 2; ++_i) \
        __builtin_amdgcn_global_load_lds((const unsigned*)((const char*)(gbase) + (voff)[_i]), (LAS unsigned*)(lds + (bufoff) + ldsw + _i * 8192), 16, 0, 0); } while (0)
#define PG8_LDA(dst, b, h) do { _Pragma("unroll") for (int m = 0; m < 4; ++m) _Pragma("unroll") for (int k = 0; k < 2; ++k) dst[m][k] = *(const LAS bf16x8*)(lds + PG8_SA(b, h) + aoff + m * 2048 + k * 1024); } while (0)
#define PG8_LDB(dst, b, h) do { _Pragma("unroll") for (int n = 0; n < 2; ++n) _Pragma("unroll") for (int k = 0; k < 2; ++k) dst[n][k] = *(const LAS bf16x8*)(lds + PG8_SB(b, h) + boff + n * 2048 + k * 1024); } while (0)
#define PG8_MMA(ai, bj, At, Bt) do { __builtin_amdgcn_s_setprio(1); _Pragma("unroll") for (int m = 0; m < 4; ++m) _Pragma("unroll") for (int n = 0; n < 2; ++n) _Pragma("unroll") for (int k = 0; k < 2; ++k) \
        acc[ai][bj][m][n] = __builtin_amdgcn_mfma_f32_16x16x32_bf16(Bt[n][k], At[m][k], acc[ai][bj][m][n], 0, 0, 0); __builtin_amdgcn_s_setprio(0); } while (0)
#define PG8_WAIT_V(n) asm volatile("s_waitcnt vmcnt(" #n ")" ::: "memory")
#define PG8_WAIT_L(n) asm volatile("s_waitcnt lgkmcnt(" #n ")" ::: "memory")
#define PG8_BAR __builtin_amdgcn_s_barrier()
#define PG8_SCHED __builtin_amdgcn_sched_barrier(0)
    Unit cur, nxt; int ui = 0;
    if (!S.next(0, cur)) return;
    f32x4 acc[2][2][4][2];
#pragma unroll
    for (int a = 0; a < 2; ++a)
#pragma unroll
        for (int b = 0; b < 2; ++b)
#pragma unroll
            for (int m = 0; m < 4; ++m)
#pragma unroll
                for (int n = 0; n < 2; ++n) acc[a][b][m][n] = (f32x4){0.f, 0.f, 0.f, 0.f};
    bf16x8 At[4][2], B0[2][2], B1[2][2];
    const char* cA = (const char*)g.A + (size_t)cur.pm * tstepA; const char* cB = (const char*)g.Bt + (size_t)cur.pn * tstepB;
    PG8_STAGE(PG8_SB(0, 0), cB, voffB); PG8_STAGE(PG8_SB(0, 1), cB + hstepB, voffB); PG8_STAGE(PG8_SA(0, 0), cA, voffA); PG8_STAGE(PG8_SA(0, 1), cA + hstepA, voffA);
    if (wr == 1) PG8_BAR;
    PG8_WAIT_V(2); PG8_BAR;
    PG8_STAGE(PG8_SB(1, 0), cB + kstep, voffB); PG8_STAGE(PG8_SA(1, 0), cA + kstep, voffA); PG8_STAGE(PG8_SB(1, 1), cB + hstepB + kstep, voffB);
    PG8_WAIT_V(6); PG8_BAR;
    for (;;) {
        const bool has_next = S.next(ui + 1, nxt);
        const char* nA = has_next ? (const char*)g.A + (size_t)nxt.pm * tstepA : cA; const char* nB = has_next ? (const char*)g.Bt + (size_t)nxt.pn * tstepB : cB;
        for (int t = 0; t < nt; t += 2) {
            const bool last = (t == nt - 2);
            const char* a1 = cA + (size_t)(t + 1) * kstep;
            const char* a2 = last ? nA : cA + (size_t)(t + 2) * kstep; const char* b2 = last ? nB : cB + (size_t)(t + 2) * kstep;
            const char* a3 = a2 + kstep; const char* b3 = b2 + kstep;
            PG8_LDB(B0, 0, 0); PG8_LDB(B1, 0, 1); PG8_SCHED; PG8_LDA(At, 0, 0); PG8_STAGE(PG8_SA(1, 1), a1 + hstepA, voffA);
            PG8_WAIT_V(8); PG8_WAIT_L(0); PG8_BAR; PG8_MMA(0, 0, At, B0); PG8_MMA(0, 1, At, B1); PG8_BAR; PG8_SCHED;
            PG8_LDA(At, 0, 1); PG8_STAGE(PG8_SB(0, 0), b2, voffB); PG8_STAGE(PG8_SB(0, 1), b2 + hstepB, voffB); PG8_STAGE(PG8_SA(0, 0), a2, voffA);
            PG8_WAIT_V(8); PG8_WAIT_L(0); PG8_BAR; PG8_MMA(1, 0, At, B0); PG8_MMA(1, 1, At, B1); PG8_BAR; PG8_SCHED;
            PG8_LDB(B0, 1, 0); PG8_LDB(B1, 1, 1); PG8_SCHED; PG8_LDA(At, 1, 0); PG8_STAGE(PG8_SA(0, 1), a2 + hstepA, voffA);
            PG8_WAIT_V(8); PG8_WAIT_L(0); PG8_BAR; PG8_MMA(0, 0, At, B0); PG8_MMA(0, 1, At, B1); PG8_BAR; PG8_SCHED;
            PG8_LDA(At, 1, 1); PG8_STAGE(PG8_SB(1, 0), b3, voffB); PG8_STAGE(PG8_SB(1, 1), b3 + hstepB, voffB); PG8_STAGE(PG8_SA(1, 0), a3, voffA);
            PG8_WAIT_V(8); PG8_WAIT_L(0); PG8_BAR; PG8_MMA(1, 0, At, B0); PG8_MMA(1, 1, At, B1); PG8_BAR; PG8_SCHED;
        }
        if constexpr (ALIGN_EPI) { if (wr == 0) PG8_BAR; }
        E(acc, cur, wr, wc, fr, fq);
        if (!has_next) break;
#pragma unroll
        for (int a = 0; a < 2; ++a)
#pragma unroll
            for (int b = 0; b < 2; ++b)
#pragma unroll
                for (int m = 0; m < 4; ++m)
#pragma unroll
                    for (int n = 0; n < 2; ++n) acc[a][b][m][n] = (f32x4){0.f, 0.f, 0.f, 0.f};
        cur = nxt; cA = nA; cB = nB; ++ui;
        if constexpr (ALIGN_EPI) { if (wr == 1) PG8_BAR; }
    }
    PG8_WAIT_V(0);
    if constexpr (!ALIGN_EPI) { if (wr == 0) PG8_BAR; }
    PG8_BAR;
#undef PG8_SA
#undef PG8_SB
#undef PG8_STAGE
#undef PG8_LDA
#undef PG8_LDB
#undef PG8_MMA
#undef PG8_WAIT_V
#undef PG8_WAIT_L
#undef PG8_BAR
#undef PG8_SCHED
}

template <class Epi>
__device__ __forceinline__ void gemm_unit_rs(LAS unsigned char* lds, const Gemm g, const Unit cur, const Epi& E) {
    const int tid = launder_v(threadIdx.x), wid = __builtin_amdgcn_readfirstlane(tid >> 6), lane = tid & 63, wr = wid >> 2, wc = wid & 3, fr = lane & 15, fq = lane >> 4;
    const int nt = g.K / BK;
    unsigned voffA[2], voffB[2];
#pragma unroll
    for (int i = 0; i < 2; ++i) { int R, C; stage_rc(tid * 16 + i * 8192, R, C); const int Rb = (R & ~31) + perm32(R & 31);
        voffA[i] = (unsigned)(R * g.lda + C) * 2u; voffB[i] = (unsigned)(Rb * g.ldb + C) * 2u; }
    const size_t hstepA = (size_t)HALF * g.lda * 2, hstepB = (size_t)HALF * g.ldb * 2;
    const char* cA = (const char*)g.A + (size_t)cur.pm * 2 * hstepA; const char* cB = (const char*)g.Bt + (size_t)cur.pn * 2 * hstepB;
    const int aoff = lds_byte(wr * 64 + fr, fq * 8), boff = lds_byte(wc * 32 + fr, fq * 8);
    const unsigned wofs = (unsigned)tid * 16u;
    f32x4 acc[2][2][4][2];
#pragma unroll
    for (int a = 0; a < 2; ++a)
#pragma unroll
        for (int b = 0; b < 2; ++b)
#pragma unroll
            for (int m = 0; m < 4; ++m)
#pragma unroll
                for (int n = 0; n < 2; ++n) acc[a][b][m][n] = (f32x4){0.f, 0.f, 0.f, 0.f};
    u32x4 st[8];
#define RS_LOAD(kt) do { const char* a_ = cA + (size_t)(kt) * (BK * 2); const char* b_ = cB + (size_t)(kt) * (BK * 2); \
        _Pragma("unroll") for (int h = 0; h < 2; ++h) _Pragma("unroll") for (int i = 0; i < 2; ++i) { \
            st[h * 2 + i] = *(const u32x4*)(a_ + h * hstepA + voffA[i]); st[4 + h * 2 + i] = *(const u32x4*)(b_ + h * hstepB + voffB[i]); } } while (0)
#define RS_STORE(buf) do { _Pragma("unroll") for (int h = 0; h < 2; ++h) _Pragma("unroll") for (int i = 0; i < 2; ++i) { \
            *(LAS u32x4*)(lds + ((buf) * 2 + h) * HTB + i * 8192 + wofs) = st[h * 2 + i]; *(LAS u32x4*)(lds + (4 + (buf) * 2 + h) * HTB + i * 8192 + wofs) = st[4 + h * 2 + i]; } } while (0)
    RS_LOAD(0); RS_STORE(0); __syncthreads();
    for (int kt = 0; kt < nt; ++kt) {
        const int b = kt & 1;
        if (kt + 1 < nt) RS_LOAD(kt + 1);
        __builtin_amdgcn_sched_barrier(0);
        bf16x8 B0[2][2], B1[2][2], At[4][2];
#pragma unroll
        for (int n = 0; n < 2; ++n)
#pragma unroll
            for (int k = 0; k < 2; ++k) { B0[n][k] = *(const LAS bf16x8*)(lds + (4 + b * 2 + 0) * HTB + boff + n * 2048 + k * 1024); B1[n][k] = *(const LAS bf16x8*)(lds + (4 + b * 2 + 1) * HTB + boff + n * 2048 + k * 1024); }
#pragma unroll
        for (int ai = 0; ai < 2; ++ai) {
#pragma unroll
            for (int m = 0; m < 4; ++m)
#pragma unroll
                for (int k = 0; k < 2; ++k) At[m][k] = *(const LAS bf16x8*)(lds + (b * 2 + ai) * HTB + aoff + m * 2048 + k * 1024);
#pragma unroll
            for (int m = 0; m < 4; ++m)
#pragma unroll
                for (int n = 0; n < 2; ++n)
#pragma unroll
                    for (int k = 0; k < 2; ++k) { acc[ai][0][m][n] = __builtin_amdgcn_mfma_f32_16x16x32_bf16(B0[n][k], At[m][k], acc[ai][0][m][n], 0, 0, 0);
                                                  acc[ai][1][m][n] = __builtin_amdgcn_mfma_f32_16x16x32_bf16(B1[n][k], At[m][k], acc[ai][1][m][n], 0, 0, 0); }
        }
        __builtin_amdgcn_sched_barrier(0);
        if (kt + 1 < nt) RS_STORE(b ^ 1);
        __syncthreads();
    }
#undef RS_LOAD
#undef RS_STORE
    E(acc, cur, wr, wc, fr, fq);
}
}

__device__ __forceinline__ float wave_sum(float v) {
#pragma unroll
    for (int o = 1; o < 64; o <<= 1) v += __shfl_xor(v, o);
    return v;
}
__device__ __forceinline__ void xpose_mat(const float* __restrict__ W, int ldw, int K, int N, bf16_t* dst, int ldt, int dcol0, const float* __restrict__ gain, int mapmode,
                                          LAS float* scr, int gw, int NGW, int lane) {
    const int nblk = N / 32, nit = (K / 64) * nblk;
    for (int it = gw; it < nit; it += NGW) {
        const int kb = it / nblk, nb = it % nblk, k0 = 64 * kb, n0 = 32 * nb;
        float wv[32];
#pragma unroll
        for (int i = 0; i < 32; ++i) wv[i] = W[(size_t)(k0 + 2 * i + (lane >> 5)) * ldw + n0 + (lane & 31)];
#pragma unroll
        for (int i = 0; i < 32; ++i) { const int kk = 2 * i + (lane >> 5); float w = wv[i]; if (gain) w *= gain[k0 + kk]; scr[kk * 33 + (lane & 31)] = w; }
        LDS_WAIT();
        const int c = lane & 7;
#pragma unroll
        for (int j = 0; j < 4; ++j) { const int n = (lane >> 3) + 8 * j; const LAS float* s = scr + (8 * c) * 33 + n;
            u32x4 o; o.x = cvt_pk_bf16(s[0 * 33], s[1 * 33]); o.y = cvt_pk_bf16(s[2 * 33], s[3 * 33]); o.z = cvt_pk_bf16(s[4 * 33], s[5 * 33]); o.w = cvt_pk_bf16(s[6 * 33], s[7 * 33]);
            const int nn = n0 + n; const int row = mapmode == 0 ? nn : (256 * (nn >> 7) + (nn & 127) + (mapmode == 2 ? 128 : 0));
            *(u32x4*)(dst + (size_t)row * ldt + dcol0 + k0 + 8 * c) = o; }
        LDS_WAIT();
    }
}
__device__ __forceinline__ void sincos_d(double x, double& s, double& c) {
    const double q = __builtin_rint(x * 0.63661977236758134308), r = (x - q * 1.57079632679489655800) - q * 6.12323399573676603587e-17;
    const double r2 = r * r;
    double sp = r * (1.0 + r2 * (-1.0 / 6 + r2 * (1.0 / 120 + r2 * (-1.0 / 5040 + r2 * (1.0 / 362880 + r2 * (-1.0 / 39916800 + r2 * (1.0 / 6227020800.0)))))));
    double cp = 1.0 + r2 * (-0.5 + r2 * (1.0 / 24 + r2 * (-1.0 / 720 + r2 * (1.0 / 40320 + r2 * (-1.0 / 3628800 + r2 * (1.0 / 479001600 + r2 * (-1.0 / 87178291200.0)))))));
    const int qi = ((int)q) & 3;
    s = (qi == 0) ? sp : (qi == 1) ? cp : (qi == 2) ? -sp : -cp;
    c = (qi == 0) ? cp : (qi == 1) ? -sp : (qi == 2) ? -cp : sp;
}

struct Args { const float* in[33]; float* out; unsigned char* ws; int ph_lo, ph_hi; };

struct S5Ctx { const bf16_t* PROJ; bf16_t* PROJw; const f32x2* Atab; const f32x2* A128; const bf16_t* Bbar; const bf16_t* Ctab; const float* Dsk; f32x2* Sloc; const f32x2* Car;
               const float* st_re; const float* st_im; float* p_re; float* p_im; float* s_re; float* s_im; };

template <bool PASSB>
__device__ __forceinline__ void s5_unit(const S5Ctx& S, LAS float* X, int lane, int m0, int g, bool sample, int b, int c) {
    const int l31 = lane & 31, lh = lane >> 5, l15 = lane & 15, lq = lane >> 4;
    bf16x8 Bf[4];
#pragma unroll
    for (int sb = 0; sb < 4; ++sb) Bf[sb] = *(const bf16x8*)(S.Bbar + ((g * 128 + 32 * sb + l31) * 16 + 8 * lh));
    const f32x2 a = {((const float*)S.Atab)[g * 64 + lane], ((const float*)S.Atab)[4096 + g * 64 + lane]};
    bf16x8 Cf[4]; f32x4 Dv = (f32x4){0.f, 0.f, 0.f, 0.f};
    if (PASSB) {
#pragma unroll
        for (int ks = 0; ks < 4; ++ks) Cf[ks] = *(const bf16x8*)(S.Ctab + ((g * 16 + l15) * 128 + 32 * ks + 8 * lq));
        Dv = *(const f32x4*)(S.Dsk + g * 16 + 4 * lq);
    }
    float hr = 0.f, hi = 0.f;
    if (PASSB && !sample && c > 0) {
        const float a128x = ((const float*)S.A128)[g * 64 + lane], a128y = ((const float*)S.A128)[4096 + g * 64 + lane];
        const float* sp = (const float*)S.Sloc + (size_t)(b * 16) * 2048 + g * 64 + lane;
        for (int j = 0; j < c; ++j) { const float svx = sp[(size_t)j * 2048], svy = sp[262144 + (size_t)j * 2048];
            const float nr = a128x * hr - a128y * hi + svx; hi = a128x * hi + a128y * hr + svy; hr = nr; }
    }
    for (int tb = 0; tb < 4; ++tb) {
        const bf16x8 Af = *(const bf16x8*)(S.PROJ + (size_t)(m0 + 32 * tb + l31) * PLD + g * 16 + 8 * lh);
#pragma unroll
        for (int sb = 0; sb < 4; ++sb) {
            f32x16 acc;
#pragma unroll
            for (int r = 0; r < 16; ++r) acc[r] = 0.f;
            acc = __builtin_amdgcn_mfma_f32_32x32x16_bf16(Af, Bf[sb], acc, 0, 0, 0);
#pragma unroll
            for (int r = 0; r < 16; ++r) X[(8 * (r >> 2) + 4 * lh + (r & 3)) * 132 + 32 * sb + l31] = acc[r];
        }
        LDS_WAIT();
#pragma unroll 8
        for (int t = 0; t < 32; ++t) {
            if (sample && (t & 3) == 0) { const int bi = b + ((32 * tb + t) >> 2); hr = S.st_re[(size_t)(bi * 32 + g) * 64 + lane]; hi = S.st_im[(size_t)(bi * 32 + g) * 64 + lane]; }
            const float xr = X[t * 132 + lane], xi = X[t * 132 + 64 + lane];
            const float nr = a.x * hr - a.y * hi + xr, ni = a.x * hi + a.y * hr + xi; hr = nr; hi = ni;
            if (PASSB) { X[t * 132 + lane] = hr; X[t * 132 + 64 + lane] = hi; }
            if (PASSB && sample && (t & 3) == 3) { const int bi = b + ((32 * tb + t) >> 2); S.s_re[(size_t)(bi * 32 + g) * 64 + lane] = hr; S.s_im[(size_t)(bi * 32 + g) * 64 + lane] = hi; }
        }
        LDS_WAIT();
        if (PASSB) {
#pragma unroll
            for (int tb2 = 0; tb2 < 2; ++tb2) {
                f32x4 acc = (f32x4){0.f, 0.f, 0.f, 0.f};
#pragma unroll
                for (int ks = 0; ks < 4; ++ks) { const LAS float* hp = X + (16 * tb2 + l15) * 132 + 32 * ks + 8 * lq;
                    const f32x4 h0 = *(const LAS f32x4*)hp, h1 = *(const LAS f32x4*)(hp + 4);
                    u32x4 hw; hw.x = cvt_pk_bf16(h0[0], h0[1]); hw.y = cvt_pk_bf16(h0[2], h0[3]); hw.z = cvt_pk_bf16(h1[0], h1[1]); hw.w = cvt_pk_bf16(h1[2], h1[3]);
                    acc = __builtin_amdgcn_mfma_f32_16x16x32_bf16(Cf[ks], __builtin_bit_cast(bf16x8, hw), acc, 0, 0, 0); }
                const size_t m = (size_t)(m0 + 32 * tb + 16 * tb2 + l15);
                const u32x2 uu = *(const u32x2*)(S.PROJ + m * PLD + g * 16 + 4 * lq);
                float y[4]; y[0] = acc[0] + Dv[0] * bf_lo(uu.x); y[1] = acc[1] + Dv[1] * bf_hi(uu.x); y[2] = acc[2] + Dv[2] * bf_lo(uu.y); y[3] = acc[3] + Dv[3] * bf_hi(uu.y);
#pragma unroll
                for (int r = 0; r < 4; ++r) y[r] = y[r] * sigmoidf_(1.5957691216057308f * (y[r] + 0.044715f * y[r] * y[r] * y[r]));
                u32x2 zw; zw.x = cvt_pk_bf16(y[0], y[1]); zw.y = cvt_pk_bf16(y[2], y[3]);
                *(u32x2*)(S.PROJw + m * PLD + 1536 + g * 16 + 4 * lq) = zw;
            }
            LDS_WAIT();
        }
    }
    if (!PASSB) { float* sp = (float*)S.Sloc + (size_t)((b * 16 + c) * 32 + g) * 64 + lane; sp[0] = hr; sp[262144] = hi; }
    if (PASSB && !sample && c == 15) { S.p_re[(size_t)(b * 32 + g) * 64 + lane] = hr; S.p_im[(size_t)(b * 32 + g) * 64 + lane] = hi; }
}

struct SguCtx { const bf16_t* PROJ; bf16_t* MIX; const float* ssqv; const float* gnorm; const bf16_t* Wm; const float* sgu_w; const float* sgu_b; float* s_v; };

__device__ __forceinline__ void sgu_unit(const SguCtx& S, LAS bf16_t* VT, int lane, int m0, int hd) {
    const int l15 = lane & 15, lq = lane >> 4;
#pragma unroll
    for (int jj = 0; jj < 2; ++jj) {
        const int j = lane + 64 * jj; const size_t m = (size_t)(m0 + j); const f32x4 q0 = *(const f32x4*)(S.ssqv + m * 4), q1 = *(const f32x4*)(S.ssqv + ((size_t)MT + m) * 4); const float rs = rstd_of(((q0[0] + q0[1]) + (q0[2] + q0[3])) + ((q1[0] + q1[1]) + (q1[2] + q1[3])), 1.0f / 512);
#pragma unroll
        for (int d8 = 0; d8 < 8; ++d8) {
            const u32x4 v = *(const u32x4*)(S.PROJ + m * PLD + 1024 + hd * 64 + 8 * d8);
            const f32x4 g0 = *(const f32x4*)(S.gnorm + hd * 64 + 8 * d8), g1 = *(const f32x4*)(S.gnorm + hd * 64 + 8 * d8 + 4);
            LAS bf16_t* p = VT + (8 * d8) * 136 + j;
            p[0 * 136] = f2bf(bf_lo(v.x) * rs * g0[0]); p[1 * 136] = f2bf(bf_hi(v.x) * rs * g0[1]); p[2 * 136] = f2bf(bf_lo(v.y) * rs * g0[2]); p[3 * 136] = f2bf(bf_hi(v.y) * rs * g0[3]);
            p[4 * 136] = f2bf(bf_lo(v.z) * rs * g1[0]); p[5 * 136] = f2bf(bf_hi(v.z) * rs * g1[1]); p[6 * 136] = f2bf(bf_lo(v.w) * rs * g1[2]); p[7 * 136] = f2bf(bf_hi(v.w) * rs * g1[3]);
        }
    }
    LDS_WAIT();
    for (int ib = 0; ib < 8; ++ib) {
        const int nks = (ib >> 1) + 1;
        bf16x8 Bw[4];
#pragma unroll
        for (int ks = 0; ks < 4; ++ks) if (ks < nks) Bw[ks] = *(const bf16x8*)(S.Wm + (size_t)((hd * 128 + 16 * ib + l15) * 128 + 32 * ks + 8 * lq));
        const int i = 16 * ib + l15; const size_t m = (size_t)(m0 + i); const float bias = S.sgu_b[hd * 128 + i];
#pragma unroll
        for (int db = 0; db < 4; ++db) {
            f32x4 acc = (f32x4){0.f, 0.f, 0.f, 0.f};
#pragma unroll
            for (int ks = 0; ks < 4; ++ks) if (ks < nks) {
                const bf16x8 Av = *(const LAS bf16x8*)(VT + (16 * db + l15) * 136 + 32 * ks + 8 * lq);
                acc = __builtin_amdgcn_mfma_f32_16x16x32_bf16(Av, Bw[ks], acc, 0, 0, 0);
            }
            const int col = hd * 64 + 16 * db + 4 * lq;
            const u32x2 uu = *(const u32x2*)(S.PROJ + m * PLD + 512 + col);
            u32x2 w; w.x = cvt_pk_bf16(bf_lo(uu.x) * (acc[0] + bias), bf_hi(uu.x) * (acc[1] + bias)); w.y = cvt_pk_bf16(bf_lo(uu.y) * (acc[2] + bias), bf_hi(uu.y) * (acc[3] + bias));
            *(u32x2*)(S.MIX + m * DM + 512 + col) = w;
        }
    }
    LDS_WAIT();
}

#define MAKE_SC S5Ctx SC{PROJ, PROJ, (const f32x2*)((const float*)(ws + WS_ATAB) + i * 2048), (const f32x2*)((const float*)(ws + WS_A128) + i * 2048), (const bf16_t*)(ws + WS_BBAR) + (size_t)i * 32 * 128 * 16, (const bf16_t*)(ws + WS_CTAB) + (size_t)i * 32 * 16 * 128, args.in[18] + i * 512, (f32x2*)(ws + WS_SLOC), (const f32x2*)(ws + WS_CAR), args.in[2] + (size_t)i * 128 * 2048, args.in[3] + (size_t)i * 128 * 2048, args.out + O_PRE + (size_t)i * 8 * 2048, args.out + O_PIM + (size_t)i * 8 * 2048, args.out + O_SRE + (size_t)i * 128 * 2048, args.out + O_SIM + (size_t)i * 128 * 2048};
#define MAKE_GC SguCtx GC{PROJ, MIX, ssqv + (size_t)i * MT * 8, args.in[21] + i * 512, (const bf16_t*)(ws + WS_WM) + (size_t)i * 8 * 128 * 128, args.in[22] + (size_t)i * 8 * 128 * 128, args.in[23] + i * 1024, args.out + O_SV + (size_t)i * 128 * 4 * 512};
#define RUN_GEMM(EPI) pg8::gemm_phase<EPI, true, pg8::StaticOrder>(lds, g, S, E)
__device__ __forceinline__ void own_grid_barrier(unsigned* cnt, unsigned target) {
    asm volatile("s_waitcnt vmcnt(0) lgkmcnt(0)" ::: "memory");
    __syncthreads();
    if (threadIdx.x == 0) {
        __builtin_amdgcn_fence(__ATOMIC_RELEASE, "agent"); asm volatile("s_waitcnt vmcnt(0)" ::: "memory");
        __hip_atomic_fetch_add(cnt, 1u, __ATOMIC_RELAXED, __HIP_MEMORY_SCOPE_AGENT);
        unsigned spins = 0;
        while (__hip_atomic_load(cnt, __ATOMIC_RELAXED, __HIP_MEMORY_SCOPE_AGENT) < target) { __builtin_amdgcn_s_sleep(1); if (++spins > (1u << 26)) break; }
    }
    __syncthreads();
    __builtin_amdgcn_fence(__ATOMIC_ACQUIRE, "agent");
}
__global__ void __launch_bounds__(512, 2) fwd_megakernel(Args args) {
    extern __shared__ __attribute__((aligned(16))) unsigned char lds_raw[];
    LAS unsigned char* lds = (LAS unsigned char*)lds_raw;
    cg::grid_group grid = cg::this_grid();
    const int G = gridDim.x, bx = blockIdx.x, NGW = G * 8, NGT = G * 512;
    const int lo = args.ph_lo, hi = args.ph_hi; int pidx = 0; int nbar = 0;
#define PH_BEGIN if (pidx >= lo && pidx < hi) { \
    const int tid = launder_v(threadIdx.x), lane = tid & 63, wave = __builtin_amdgcn_readfirstlane(tid >> 6); \
    const int gw = bx * 8 + wave, gt = bx * 512 + tid; (void)gw; (void)gt; (void)lane; \
    const size_t lz_ = launder_zero(); unsigned char* ws = args.ws + lz_; float* H = args.out + lz_; \
    float* ssq = (float*)(ws + WS_SSQ); float* ssqv = (float*)(ws + WS_SSQV); (void)ssqv; bf16_t* HB = (bf16_t*)(ws + WS_HB); bf16_t* PROJ = (bf16_t*)(ws + WS_PROJ); bf16_t* MIX = (bf16_t*)(ws + WS_MIX); bf16_t* ACT = (bf16_t*)(ws + WS_ACT); \
    (void)ssq; (void)HB; (void)PROJ; (void)MIX; (void)ACT; (void)H; \
    LAS unsigned char* wreg = lds + wave * WREG; (void)wreg;
#define PH_END } if (pidx >= lo && pidx + 1 < hi) { own_grid_barrier((unsigned*)(args.ws + WS_BAR), (unsigned)(++nbar) * (unsigned)G); } ++pidx;

    PH_BEGIN
    {
        LAS float* scr = (LAS float*)wreg;
        for (int i = 0; i < 2; ++i) {
            const int Le = 2 * i, Lo = 2 * i + 1;
            xpose_mat(args.in[9] + (size_t)i * DM * 1536, 1536, DM, 1536, (bf16_t*)(ws + WS_W1E + i * 3 * MiB), DM, 0, args.in[6] + Le * DM, 0, scr, gw, NGW, lane);
            xpose_mat(args.in[10] + (size_t)i * DM * DM, DM, DM, DM, (bf16_t*)(ws + WS_WOE + i * 2 * MiB), DM, 0, nullptr, 0, scr, gw, NGW, lane);
            xpose_mat(args.in[19] + (size_t)i * 512 * 512, 512, 512, 512, (bf16_t*)(ws + WS_GLU + i * (MiB / 2)), 512, 0, nullptr, 0, scr, gw, NGW, lane);
            xpose_mat(args.in[24] + (size_t)i * DM * 2048, 2048, DM, 2048, (bf16_t*)(ws + WS_W1O + i * 4 * MiB), DM, 0, args.in[6] + Lo * DM, 0, scr, gw, NGW, lane);
            xpose_mat(args.in[25] + (size_t)i * DM * DM + (size_t)512 * DM, DM, 512, DM, (bf16_t*)(ws + WS_WOO + i * 2 * MiB), DM, 512, nullptr, 0, scr, gw, NGW, lane);
        }
        for (int L = 0; L < 4; ++L) {
            bf16_t* wgu = (bf16_t*)(ws + WS_WGU + L * 11 * MiB);
            xpose_mat(args.in[30] + (size_t)L * DM * FF, FF, DM, FF, wgu, DM, 0, args.in[7] + L * DM, 1, scr, gw, NGW, lane);
            xpose_mat(args.in[31] + (size_t)L * DM * FF, FF, DM, FF, wgu, DM, 0, args.in[7] + L * DM, 2, scr, gw, NGW, lane);
            xpose_mat(args.in[32] + (size_t)L * FF * DM, DM, FF, DM, (bf16_t*)(ws + WS_WD + L * (11 * MiB / 2)), FF, 0, nullptr, 0, scr, gw, NGW, lane);
        }
        for (int it = gw; it < 2 * 4 * 2 * 128; it += NGW) {
            const int i = it >> 10, g = (it >> 8) & 3, ch = (it >> 7) & 1, n0 = (it & 127) * 8, c = ch * 64 + lane;
            const float* pw = args.in[26] + (size_t)((i * 4 + g) * 128 + c) * 128; const float* sc = args.in[27] + i * 512 + g * 128;
            const float* wo = args.in[25] + (size_t)i * DM * DM + (size_t)(g * 128) * DM + n0;
            float s8[8];
#pragma unroll
            for (int e = 0; e < 8; ++e) s8[e] = 0.f;
            for (int d = 0; d < 128; d += 4) {
                const f32x4 p4 = *(const f32x4*)(pw + d);
#pragma unroll
                for (int dd = 0; dd < 4; ++dd) { const float ps = p4[dd] * sc[d + dd]; const f32x4 w0 = *(const f32x4*)(wo + (size_t)(d + dd) * DM), w1 = *(const f32x4*)(wo + (size_t)(d + dd) * DM + 4);
                    s8[0] += ps * w0[0]; s8[1] += ps * w0[1]; s8[2] += ps * w0[2]; s8[3] += ps * w0[3]; s8[4] += ps * w1[0]; s8[5] += ps * w1[1]; s8[6] += ps * w1[2]; s8[7] += ps * w1[3]; }
            }
            bf16_t* dst = (bf16_t*)(ws + WS_WOO + i * 2 * MiB) + (size_t)n0 * DM + g * 128 + c;
#pragma unroll
            for (int e = 0; e < 8; ++e) dst[(size_t)e * DM] = f2bf(s8[e]);
        }
        for (int it = gt; it < 2 * 32 * 64; it += NGT) {
            const int i = it >> 11, g = (it >> 6) & 31, n = it & 63;
            const float lr = args.in[11][it], li = args.in[12][it], dt = expf(args.in[13][i * 32 + g]);
            const double mag = (double)expf(lr * dt); double sn, cs; sincos_d((double)li * (double)dt, sn, cs);
            const double ar = mag * cs, ai = mag * sn, den = (double)lr * lr + (double)li * li;
            const float fr = (float)(((ar - 1.0) * lr + ai * li) / den), fi = (float)((ai * lr - (ar - 1.0) * li) / den);
            ((float*)(ws + WS_ATAB))[it] = (float)ar; ((float*)(ws + WS_ATAB))[4096 + it] = (float)ai;
            double pr = ar, pi = ai;
#pragma unroll
            for (int s = 0; s < 7; ++s) { const double t = pr * pr - pi * pi; pi = 2.0 * pr * pi; pr = t; }
            ((float*)(ws + WS_A128))[it] = (float)pr; ((float*)(ws + WS_A128))[4096 + it] = (float)pi;
            bf16_t* bb = (bf16_t*)(ws + WS_BBAR); bf16_t* ct = (bf16_t*)(ws + WS_CTAB);
#pragma unroll 4
            for (int p = 0; p < 16; ++p) {
                const float br = args.in[14][(size_t)it * 16 + p], bi = args.in[15][(size_t)it * 16 + p];
                bb[(size_t)((i * 32 + g) * 128 + n) * 16 + p] = f2bf(fr * br - fi * bi); bb[(size_t)((i * 32 + g) * 128 + 64 + n) * 16 + p] = f2bf(fr * bi + fi * br);
                const size_t ci = (size_t)((i * 32 + g) * 16 + p) * 64 + n;
                ct[(size_t)((i * 32 + g) * 16 + p) * 128 + n] = f2bf(args.in[16][ci]); ct[(size_t)((i * 32 + g) * 16 + p) * 128 + 64 + n] = f2bf(-args.in[17][ci]);
            }
        }
        for (int it = gt; it < 2 * 8 * 128 * 128; it += NGT) { const int r = (it >> 7) & 127, c = it & 127; ((bf16_t*)(ws + WS_WM))[it] = c <= r ? f2bf(args.in[22][it]) : (bf16_t)0; }
        for (int m = gw; m < MT; m += NGW) {
            const float* src = m < MP ? args.in[0] + (size_t)m * DM : args.in[1] + (size_t)(m - MP) * DM;
            float s = 0.f;
#pragma unroll
            for (int j = 0; j < 4; ++j) { const f32x4 v = ((const f32x4*)src)[lane + 64 * j]; s += (v[0] * v[0] + v[1] * v[1]) + (v[2] * v[2] + v[3] * v[3]);
                u32x2 w; w.x = cvt_pk_bf16(v[0], v[1]); w.y = cvt_pk_bf16(v[2], v[3]); ((u32x2*)(HB + (size_t)m * DM))[lane + 64 * j] = w; }
            s = wave_sum(s); if (lane < 16) ssq[((size_t)(lane >> 2) * MT + m) * 4 + (lane & 3)] = lane == 0 ? s : 0.f;
        }
    }
    PH_END

    for (int L = 0; L < DBG_LAYERS; ++L) {
        const int i = L >> 1; const bool even = (L & 1) == 0;
        PH_BEGIN
        {
            const int N = even ? 1536 : 2048;
            pg8::Gemm g{HB, (const bf16_t*)(ws + (even ? WS_W1E + i * 3 * MiB : WS_W1O + i * 4 * MiB)), MT, N, DM, DM, DM};
            pg8::StaticOrder S; S.init(MT, N, G, bx);
            pg8::EpiProj E{PROJ, PLD, ssq + (size_t)(2 * L) * MT * 16, even ? ssqv + (size_t)i * MT * 8 : nullptr, 1024};
            RUN_GEMM(pg8::EpiProj);
        }
        PH_END
        if (even) {
            PH_BEGIN
#if defined(DBG_NOMIX)
            { for (int it = gt; it < MT * 64; it += NGT) { const int m = it >> 6, c8 = it & 63; *(u32x4*)(MIX + (size_t)m * DM + 8 * c8) = *(const u32x4*)(PROJ + (size_t)m * PLD + 8 * c8); } }
#endif
            {
                MAKE_SC MAKE_GC
                for (int wu = gw; wu < 3840 + 1024; wu += NGW) {
                    if (wu < 3840) { const int g = wu & 31, bc = wu >> 5, b = bc / 15, c = bc % 15; s5_unit<false>(SC, (LAS float*)wreg, lane, b * SEQ + c * 128, g, false, b, c); }
                    else { const int su = wu - 3840, hd = su & 7, bc = su >> 3; sgu_unit(GC, (LAS bf16_t*)wreg, lane, bc * 128, hd); }
                }
                for (int it = gt; it < MSAMP * 64; it += NGT) {
                    const int sr = it >> 6, c8 = it & 63, col = 8 * c8, hd = col >> 6, b = sr >> 2, t = sr & 3;
                    float mix[8], vt[8];
#pragma unroll
                    for (int e = 0; e < 8; ++e) { mix[e] = 0.f; vt[e] = 0.f; }
                    const f32x4 g0 = *(const f32x4*)(GC.gnorm + col), g1 = *(const f32x4*)(GC.gnorm + col + 4);
                    for (int j = 0; j <= t; ++j) {
                        const size_t mj = (size_t)(MP + 4 * b + j); const f32x4 q0 = *(const f32x4*)(GC.ssqv + mj * 4), q1 = *(const f32x4*)(GC.ssqv + ((size_t)MT + mj) * 4); const float rs = rstd_of(((q0[0] + q0[1]) + (q0[2] + q0[3])) + ((q1[0] + q1[1]) + (q1[2] + q1[3])), 1.0f / 512);
                        const u32x4 v = *(const u32x4*)(PROJ + mj * PLD + 1024 + col);
                        float vn[8]; vn[0] = bf_lo(v.x) * rs * g0[0]; vn[1] = bf_hi(v.x) * rs * g0[1]; vn[2] = bf_lo(v.y) * rs * g0[2]; vn[3] = bf_hi(v.y) * rs * g0[3];
                        vn[4] = bf_lo(v.z) * rs * g1[0]; vn[5] = bf_hi(v.z) * rs * g1[1]; vn[6] = bf_lo(v.w) * rs * g1[2]; vn[7] = bf_hi(v.w) * rs * g1[3];
                        const float w = GC.sgu_w[(size_t)(hd * 128 + t) * 128 + j];
#pragma unroll
                        for (int e = 0; e < 8; ++e) { mix[e] += w * vn[e]; vt[e] = vn[e]; }
                    }
                    const float bias = GC.sgu_b[hd * 128 + t]; const size_t m = (size_t)(MP + sr);
                    const u32x4 uu = *(const u32x4*)(PROJ + m * PLD + 512 + col);
                    u32x4 w; w.x = cvt_pk_bf16(bf_lo(uu.x) * (mix[0] + bias), bf_hi(uu.x) * (mix[1] + bias)); w.y = cvt_pk_bf16(bf_lo(uu.y) * (mix[2] + bias), bf_hi(uu.y) * (mix[3] + bias));
                    w.z = cvt_pk_bf16(bf_lo(uu.z) * (mix[4] + bias), bf_hi(uu.z) * (mix[5] + bias)); w.w = cvt_pk_bf16(bf_lo(uu.w) * (mix[6] + bias), bf_hi(uu.w) * (mix[7] + bias));
                    *(u32x4*)(MIX + m * DM + 512 + col) = w;
                    float* sv = GC.s_v + (size_t)sr * 512 + col;
                    *(f32x4*)sv = (f32x4){vt[0], vt[1], vt[2], vt[3]}; *(f32x4*)(sv + 4) = (f32x4){vt[4], vt[5], vt[6], vt[7]};
                }
            }
            PH_END
            PH_BEGIN
            {
                MAKE_SC
                for (int wu = gw; wu < 4096 + 128; wu += NGW) {
                    if (wu < 4096) { const int g = wu & 31, bc = wu >> 5, b = bc >> 4, c = bc & 15; s5_unit<true>(SC, (LAS float*)wreg, lane, b * SEQ + c * 128, g, false, b, c); }
                    else { const int su = wu - 4096, g = su & 31, sbk = su >> 5; s5_unit<true>(SC, (LAS float*)wreg, lane, MP + 128 * sbk, g, true, 32 * sbk, 0); }
                }
            }
            PH_END
            PH_BEGIN
#if defined(DBG_NOMIX)
            if (0)
#endif
            {
                pg8::Gemm g{PROJ + 1536, (const bf16_t*)(ws + WS_GLU + i * (MiB / 2)), MT, 512, 512, PLD, 512};
                pg8::StaticOrder S; S.init(MT, 512, G, bx);
                pg8::EpiGlu E{MIX, DM, PROJ + 1536, PLD, args.in[20] + i * 512};
                RUN_GEMM(pg8::EpiGlu);
            }
            PH_END
        } else {
            PH_BEGIN
#if defined(DBG_NOMIX_ODD)
            { for (int it = gt; it < MT * 128; it += NGT) { const int m = it >> 7, c8 = it & 127; *(u32x4*)(MIX + (size_t)m * DM + 8 * c8) = *(const u32x4*)(PROJ + (size_t)m * PLD + 8 * c8); } }
            if (0)
#endif
            {
                const float* spool = args.in[4] + (size_t)i * 128 * 15 * 512; const float* sconv = args.in[5] + (size_t)i * 128 * 2 * 512;
                const float* cw = args.in[28] + i * 3 * 512; const float* cb = args.in[29] + i * 512;
                float* ppool = args.out + O_PPOOL + (size_t)i * 8 * 15 * 512; float* pconv = args.out + O_PCONV + (size_t)i * 8 * 2 * 512;
                float* opool = args.out + O_SPOOL + (size_t)i * 128 * 15 * 512; float* oconv = args.out + O_SCONV + (size_t)i * 128 * 2 * 512;
                for (int it = gt; it < MT * 128; it += NGT) {
                    const int m = it >> 7, c8 = it & 127, col = 8 * c8; const bool samp = m >= MP;
                    const int b = samp ? (m - MP) >> 2 : m >> 11, t = samp ? (m - MP) & 3 : m & 2047;
                    if (col < 512) {
                        const int w = 2 << (col >> 7);
                        float s[8], x0[8];
#pragma unroll
                        for (int e = 0; e < 8; ++e) s[e] = 0.f;
                        int n = 0;
                        if (!samp) {
                            n = t + 1 < w ? t + 1 : w;
                            for (int k0 = 0; k0 < n; k0 += 4) {
                                u32x4 v[4];
#pragma unroll
                                for (int kk = 0; kk < 4; ++kk) { const int k = k0 + kk < n ? k0 + kk : 0; v[kk] = *(const u32x4*)(PROJ + (size_t)(m - k) * PLD + col); }
#pragma unroll
                                for (int kk = 0; kk < 4; ++kk) { const float f0 = bf_lo(v[kk].x), f1 = bf_hi(v[kk].x), f2 = bf_lo(v[kk].y), f3 = bf_hi(v[kk].y), f4 = bf_lo(v[kk].z), f5 = bf_hi(v[kk].z), f6 = bf_lo(v[kk].w), f7 = bf_hi(v[kk].w);
                                    if (k0 + kk == 0) { x0[0] = f0; x0[1] = f1; x0[2] = f2; x0[3] = f3; x0[4] = f4; x0[5] = f5; x0[6] = f6; x0[7] = f7; }
                                    if (k0 + kk < n) { s[0] += f0; s[1] += f1; s[2] += f2; s[3] += f3; s[4] += f4; s[5] += f5; s[6] += f6; s[7] += f7; } }
                            }
                        } else
                        for (int k = 0; k < w; ++k) {
                            const int p = t - k;
                            if (p >= 0) { const u32x4 v = *(const u32x4*)(PROJ + (size_t)(m - k) * PLD + col);
                                float f[8]; f[0] = bf_lo(v.x); f[1] = bf_hi(v.x); f[2] = bf_lo(v.y); f[3] = bf_hi(v.y); f[4] = bf_lo(v.z); f[5] = bf_hi(v.z); f[6] = bf_lo(v.w); f[7] = bf_hi(v.w);
#pragma unroll
                                for (int e = 0; e < 8; ++e) { s[e] += f[e]; if (k == 0) x0[e] = f[e]; }
                                ++n; }
                            else if (samp) { const float* q = spool + (size_t)(b * 15 + 15 + p) * 512 + col; const f32x4 a0 = *(const f32x4*)q, a1 = *(const f32x4*)(q + 4);
                                s[0] += a0[0]; s[1] += a0[1]; s[2] += a0[2]; s[3] += a0[3]; s[4] += a1[0]; s[5] += a1[1]; s[6] += a1[2]; s[7] += a1[3]; ++n; }
                        }
                        const float inv = 1.0f / (float)n;
                        u32x4 o; o.x = cvt_pk_bf16(s[0] * inv - x0[0], s[1] * inv - x0[1]); o.y = cvt_pk_bf16(s[2] * inv - x0[2], s[3] * inv - x0[3]);
                        o.z = cvt_pk_bf16(s[4] * inv - x0[4], s[5] * inv - x0[5]); o.w = cvt_pk_bf16(s[6] * inv - x0[6], s[7] * inv - x0[7]);
                        *(u32x4*)(MIX + (size_t)m * DM + col) = o;
                        if (!samp) { if (t >= SEQ - 15) { float* q = ppool + (size_t)(b * 15 + t - (SEQ - 15)) * 512 + col; *(f32x4*)q = (f32x4){x0[0], x0[1], x0[2], x0[3]}; *(f32x4*)(q + 4) = (f32x4){x0[4], x0[5], x0[6], x0[7]}; } }
                        else { float* q = opool + (size_t)(b * 15 + 11 + t) * 512 + col; *(f32x4*)q = (f32x4){x0[0], x0[1], x0[2], x0[3]}; *(f32x4*)(q + 4) = (f32x4){x0[4], x0[5], x0[6], x0[7]};
                            if (t == 0) for (int r = 0; r < 11; ++r) { const float* sp = spool + (size_t)(b * 15 + r + 4) * 512 + col; float* dp = opool + (size_t)(b * 15 + r) * 512 + col;
                                *(f32x4*)dp = *(const f32x4*)sp; *(f32x4*)(dp + 4) = *(const f32x4*)(sp + 4); } }
                    } else {
                        const int d = col - 512;
                        float z[3][8];
#pragma unroll
                        for (int k = 0; k < 3; ++k) {
                            const int p = t - k;
                            if (p >= 0) { const u32x4 xv = *(const u32x4*)(PROJ + (size_t)(m - k) * PLD + 512 + d), cv = *(const u32x4*)(PROJ + (size_t)(m - k) * PLD + 1536 + d);
                                z[k][0] = bf_lo(xv.x) * bf_lo(cv.x); z[k][1] = bf_hi(xv.x) * bf_hi(cv.x); z[k][2] = bf_lo(xv.y) * bf_lo(cv.y); z[k][3] = bf_hi(xv.y) * bf_hi(cv.y);
                                z[k][4] = bf_lo(xv.z) * bf_lo(cv.z); z[k][5] = bf_hi(xv.z) * bf_hi(cv.z); z[k][6] = bf_lo(xv.w) * bf_lo(cv.w); z[k][7] = bf_hi(xv.w) * bf_hi(cv.w); }
                            else if (samp) { const float* q = sconv + (size_t)(b * 2 + 2 + p) * 512 + d; const f32x4 a0 = *(const f32x4*)q, a1 = *(const f32x4*)(q + 4);
                                z[k][0] = a0[0]; z[k][1] = a0[1]; z[k][2] = a0[2]; z[k][3] = a0[3]; z[k][4] = a1[0]; z[k][5] = a1[1]; z[k][6] = a1[2]; z[k][7] = a1[3]; }
                            else {
#pragma unroll
                                for (int e = 0; e < 8; ++e) z[k][e] = 0.f; }
                        }
                        const u32x4 bg = *(const u32x4*)(PROJ + (size_t)m * PLD + 1024 + d);
                        float bgf[8]; bgf[0] = bf_lo(bg.x); bgf[1] = bf_hi(bg.x); bgf[2] = bf_lo(bg.y); bgf[3] = bf_hi(bg.y); bgf[4] = bf_lo(bg.z); bgf[5] = bf_hi(bg.z); bgf[6] = bf_lo(bg.w); bgf[7] = bf_hi(bg.w);
                        float y[8];
#pragma unroll
                        for (int e = 0; e < 8; ++e) y[e] = bgf[e] * (cb[d + e] + z[2][e] * cw[d + e] + z[1][e] * cw[512 + d + e] + z[0][e] * cw[1024 + d + e]);
                        u32x4 o; o.x = cvt_pk_bf16(y[0], y[1]); o.y = cvt_pk_bf16(y[2], y[3]); o.z = cvt_pk_bf16(y[4], y[5]); o.w = cvt_pk_bf16(y[6], y[7]);
                        *(u32x4*)(MIX + (size_t)m * DM + col) = o;
                        float* q = nullptr;
                        if (!samp) { if (t >= SEQ - 2) q = pconv + (size_t)(b * 2 + t - (SEQ - 2)) * 512 + d; } else { if (t >= 2) q = oconv + (size_t)(b * 2 + t - 2) * 512 + d; }
                        if (q) { *(f32x4*)q = (f32x4){z[0][0], z[0][1], z[0][2], z[0][3]}; *(f32x4*)(q + 4) = (f32x4){z[0][4], z[0][5], z[0][6], z[0][7]}; }
                    }
                }
            }
            PH_END
        }
        PH_BEGIN
        {
            pg8::Gemm g{MIX, (const bf16_t*)(ws + (even ? WS_WOE : WS_WOO) + i * 2 * MiB), MT, DM, DM, DM, DM};
            pg8::StaticOrder S; S.init(MT, DM, G, bx);
            pg8::EpiResid E{H, HB, ssq + (size_t)(2 * L + 1) * MT * 16, L == 0 ? args.in[0] : nullptr, L == 0 ? args.in[1] : nullptr};
            RUN_GEMM(pg8::EpiResid);
        }
        PH_END
        PH_BEGIN
        {
            pg8::Gemm g{HB, (const bf16_t*)(ws + WS_WGU + L * 11 * MiB), MT, NGU, DM, DM, DM};
            pg8::StaticOrder S; S.init(MT, NGU, G, bx);
            pg8::EpiSwiglu E{ACT, ssq + (size_t)(2 * L + 1) * MT * 16};
            RUN_GEMM(pg8::EpiSwiglu);
        }
        PH_END
        PH_BEGIN
        {
            pg8::Gemm g{ACT, (const bf16_t*)(ws + WS_WD + L * (11 * MiB / 2)), MT, DM, FF, FF, FF};
            pg8::StaticOrder S; S.init(MT, DM, G, bx);
            pg8::EpiResid E{H, HB, ssq + (size_t)(2 * L + 2) * MT * 16, nullptr, nullptr};
            RUN_GEMM(pg8::EpiResid);
        }
        PH_END
    }
    PH_BEGIN
    {
        const float* sq = ssq + (size_t)8 * MT * 16; const f32x4* gf = (const f32x4*)args.in[8];
        for (int it = gt; it < MT * 256; it += NGT) { const int m = it >> 8, c4 = it & 255; const f32x4* q = (const f32x4*)sq + m; const f32x4 qa = q[0], qb = q[(size_t)MT], qc = q[(size_t)2 * MT], qd = q[(size_t)3 * MT];
            const float rs = rstd_of((((qa[0] + qa[1]) + (qa[2] + qa[3])) + ((qb[0] + qb[1]) + (qb[2] + qb[3]))) + (((qc[0] + qc[1]) + (qc[2] + qc[3])) + ((qd[0] + qd[1]) + (qd[2] + qd[3]))), 1.0f / DM);
            f32x4 v = ((f32x4*)H)[it]; const f32x4 gg = gf[c4]; v = v * rs * gg; ((f32x4*)H)[it] = v; }
    }
    PH_END
    if (hi - lo > 1) grid.sync();
#if defined(DBG_MASK)
    PH_BEGIN
    {
        float* o = args.out; (void)ws;
        for (size_t it = (size_t)gt; it < O_END; it += NGT) {
            int cls;
            if (it < (size_t)MP * DM) cls = 0; else if (it < O_PRE) cls = 1; else if (it < O_PPOOL) cls = 2; else if (it < O_SRE) cls = 3; else if (it < O_SV) cls = 2; else if (it < O_SPOOL) cls = 4; else cls = 3;
            if ((DBG_MASK >> cls) & 1) o[it] = 0.f;
        }
    }
    PH_END
#endif
#undef PH_BEGIN
#undef PH_END
#if defined(DBG_STOP)
    if (lo == 99) {
        const int tid = threadIdx.x; unsigned char* ws = args.ws; float* o = args.out + O_SPOOL;
        const int NEL = (int)(O_END - O_SPOOL);
        for (int it = bx * 512 + tid; it < NEL; it += NGT) {
            float v;
            if (DBG_SRC == 0) { const int r = it >> 10, c = it & 1023; const int row = MP + (r % MSAMP); v = bf1(f2bf(args.out[(size_t)row * DM + c])); }
            else if (DBG_SRC == 1) { const int r = it >> 11, c = it & 2047; const int row = MP + (r % MSAMP); v = bf1(((const bf16_t*)(ws + WS_PROJ))[(size_t)row * PLD + c]); }
            else if (DBG_SRC == 2) { const int r = it >> 10, c = it & 1023; const int row = MP + (r % MSAMP); v = bf1(((const bf16_t*)(ws + WS_MIX))[(size_t)row * DM + c]); }
            else if (DBG_SRC == 5) { const int r = (it >> 11) % MSAMP, c = it & 2047; if (it >= MSAMP * 2048) { o[it] = 0.f; continue; }
                const bf16_t* a = (const bf16_t*)(ws + WS_HB) + (size_t)(MP + r) * DM; const bf16_t* w = (const bf16_t*)(ws + WS_W1O + 4 * MiB) + (size_t)c * DM; float acc = 0.f;
                for (int k = 0; k < DM; ++k) acc += bf1(a[k]) * bf1(w[k]);
                v = bf1(f2bf(acc)); }
            else if (DBG_SRC == 4) { const int r = it >> 10, c = it & 1023; const int row = MP + (r % MSAMP); v = bf1(((const bf16_t*)(ws + WS_HB))[(size_t)row * DM + c]); }
            else { const int r = it / FF, c = it % FF; const int row = MP + (r % MSAMP); v = bf1(((const bf16_t*)(ws + WS_ACT))[(size_t)row * FF + c]); }
            o[it] = v;
        }
    }
#endif
}

#if defined(DBG_MASK)
constexpr int N_PHASES = 1 + 2 * 7 + 2 * 5 + 2;
#else
constexpr int N_PHASES = 1 + 2 * 7 + 2 * 5 + 1;
#endif

extern "C" void kernel_launch(void* const* d_in, const int* in_sizes, int n_in, void* d_out, int out_size, void* d_ws, size_t ws_size, hipStream_t stream) {
    static int grid = 0;
    if (grid == 0) {
        if (n_in != 33 || out_size != (int)O_END || ws_size < WS_END) { fprintf(stderr, "kernel_launch: unexpected shapes n_in %d out %d ws %zu\n", n_in, out_size, ws_size); grid = -1; return; }
        int dev = 0, cus = 0, per_cu = 0;
        hipGetDevice(&dev); hipDeviceGetAttribute(&cus, hipDeviceAttributeMultiprocessorCount, dev);
        hipFuncSetAttribute((const void*)fwd_megakernel, hipFuncAttributeMaxDynamicSharedMemorySize, LDS_BYTES);
        hipOccupancyMaxActiveBlocksPerMultiprocessor(&per_cu, (const void*)fwd_megakernel, 512, LDS_BYTES);
        if (per_cu < 1) { fprintf(stderr, "kernel_launch: occupancy query says %d blocks per CU\n", per_cu); per_cu = 1; }
        (void)hipGetLastError();
        grid = cus;
    }
    if (grid < 0) return;
#if defined(DBG_FILLWS)
    (void)hipMemsetAsync((char*)d_ws + DBG_F0 * MiB, 0, (size_t)(DBG_F1 - DBG_F0) * MiB, stream); (void)hipMemsetAsync(d_out, 0, O_END * 4, stream);
#endif
#if defined(DBG_TINYSET)
    (void)hipMemsetAsync((char*)d_ws + 255 * MiB, 0, 256, stream); (void)hipMemsetAsync((char*)d_ws + 255 * MiB + 4096, 0, 256, stream);
#endif
    (void)hipMemsetAsync((char*)d_ws + WS_BAR, 0, 256, stream);
    Args a{};
    for (int i = 0; i < 33; ++i) a.in[i] = (const float*)d_in[i];
    a.out = (float*)d_out; a.ws = (unsigned char*)d_ws;
#if MK_PER_PHASE
#if defined(DBG_STOP)
    for (int p = 0; p < DBG_STOP; ++p) { a.ph_lo = p; a.ph_hi = p + 1; hipLaunchKernelGGL(fwd_megakernel, dim3(grid), dim3(512), LDS_BYTES, stream, a); }
    a.ph_lo = 99; a.ph_hi = 100; hipLaunchKernelGGL(fwd_megakernel, dim3(grid), dim3(512), LDS_BYTES, stream, a);
#else
    for (int p = 0; p < N_PHASES; ++p) { a.ph_lo = p; a.ph_hi = p + 1; hipLaunchKernelGGL(fwd_megakernel, dim3(grid), dim3(512), LDS_BYTES, stream, a); }
#endif
#else
    a.ph_lo = 0; a.ph_hi = N_PHASES;
    void* kargs[] = {&a};
    hipError_t e = hipLaunchCooperativeKernel((const void*)fwd_megakernel, dim3(grid), dim3(512), kargs, LDS_BYTES, stream);
    if (e != hipSuccess) fprintf(stderr, "cooperative launch failed: %s (grid %d)\n", hipGetErrorString(e), grid);
#endif
}
```

```cpp
#include <hip/hip_runtime.h>
#include <hip/hip_cooperative_groups.h>
#include <cstdio>
#include <cstdint>
namespace cg = cooperative_groups;

#ifndef MK_PER_PHASE
#define MK_PER_PHASE 0
#endif

#ifndef DBG_LAYERS
#define DBG_LAYERS 4
#endif
#ifndef DBG_SKIP
#define DBG_SKIP 0
#endif
#define LAS __attribute__((address_space(3)))
typedef unsigned short bf16_t;
typedef short bf16x8 __attribute__((ext_vector_type(8)));
typedef float f32x2 __attribute__((ext_vector_type(2)));
typedef float f32x4 __attribute__((ext_vector_type(4)));
typedef float f32x16 __attribute__((ext_vector_type(16)));
typedef unsigned u32x4 __attribute__((ext_vector_type(4)));
typedef unsigned u32x2 __attribute__((ext_vector_type(2)));

constexpr int DM = 1024, MP = 16384, MSAMP = 512, MT = MP + MSAMP, FF = 2816, NGU = 2 * FF, SEQ = 2048;
constexpr float EPS = 1e-6f;
constexpr int PLD = 2048;
constexpr size_t O_Y = 0, O_PRE = 17301504, O_PIM = 17334272, O_PPOOL = 17367040, O_PCONV = 17489920, O_SRE = 17506304, O_SIM = 18030592,
                 O_SV = 18554880, O_SPOOL = 19079168, O_SCONV = 21045248, O_END = 21307392;
constexpr size_t MiB = 1u << 20;
constexpr size_t WS_SSQ = 226 * MiB, WS_SSQV = 237 * MiB;
constexpr size_t WS_ATAB = 1 * MiB, WS_A128 = WS_ATAB + 32768, WS_BBAR = WS_ATAB + 65536, WS_CTAB = WS_BBAR + 262144, WS_WM = WS_CTAB + 262144;
constexpr size_t WS_SLOC = 3 * MiB;
constexpr size_t WS_W1E = 5 * MiB, WS_WOE = 11 * MiB, WS_GLU = 15 * MiB, WS_W1O = 16 * MiB, WS_WOO = 24 * MiB, WS_WGU = 28 * MiB, WS_WD = 72 * MiB;
constexpr size_t WS_HB = 94 * MiB, WS_PROJ = 127 * MiB, WS_MIX = 193 * MiB, WS_ACT = 127 * MiB, WS_ACT_END = 226 * MiB, WS_CAR = 239 * MiB, WS_BAR = 0, WS_END = 241 * MiB;
static_assert(WS_WM + 524288 <= WS_SLOC && WS_SSQ + 9 * (size_t)MT * 64 <= WS_SSQV && WS_SSQV + 2 * (size_t)MT * 32 <= 239 * MiB, "ws map");
static_assert(WS_ACT + (size_t)MT * FF * 2 <= WS_ACT_END, "act overlay");

constexpr int LDS_BYTES = 147456;
constexpr int WREG = 17408;

typedef __bf16 bf16x2_t __attribute__((ext_vector_type(2)));
__device__ __forceinline__ unsigned cvt_pk_bf16(float lo, float hi) { const f32x2 v = {lo, hi}; const bf16x2_t b = __builtin_convertvector(v, bf16x2_t); return __builtin_bit_cast(unsigned, b); }
__device__ __forceinline__ float bf_lo(unsigned w) { return __uint_as_float(w << 16); }
__device__ __forceinline__ float bf_hi(unsigned w) { return __uint_as_float(w & 0xffff0000u); }
__device__ __forceinline__ float bf1(bf16_t b) { return __uint_as_float((unsigned)b << 16); }
__device__ __forceinline__ bf16_t f2bf(float f) { return (bf16_t)(cvt_pk_bf16(f, 0.f) & 0xffffu); }
__device__ __forceinline__ float rstd_of(float ssq, float invn) { return rsqrtf(ssq * invn + EPS); }
__device__ __forceinline__ float sigmoidf_(float x) { return __builtin_amdgcn_rcpf(1.0f + __expf(-x)); }
#define LDS_WAIT() asm volatile("s_waitcnt lgkmcnt(0)" ::: "memory")
__device__ __forceinline__ float row_ssq16(const float* part, int row, int fq) { const f32x4 p = *(const f32x4*)(part + ((size_t)fq * MT + row) * 4);     float s = (p[0] + p[1]) + (p[2] + p[3]); s += __shfl_xor(s, 16); s += __shfl_xor(s, 32); return s; }
__device__ __forceinline__ int launder_v(int x) { asm volatile("" : "+v"(x)); return x; }
__device__ __forceinline__ size_t launder_zero() { size_t z = 0; asm volatile("" : "+s"(z)); return z; }

namespace pg8 {
constexpr int BM = 256, BK = 64, HALF = 128, HTB = HALF * BK * 2, STAGE_BYTES = 8 * HTB, NXCD = 8, WGM = 8;
__host__ __device__ __forceinline__ int lds_byte(int r, int c) { const int st = (r >> 4) * 2 + (c >> 5), rr = r & 15, cc = c & 31, ob = rr * 64 + cc * 2; return st * 1024 + (ob ^ (((ob >> 9) & 1) << 5)); }
__host__ __device__ __forceinline__ void stage_rc(int b, int& R, int& C) { const int st = b / 1024, sb = b % 1024, swz = sb ^ (((sb >> 9) & 1) << 5); R = (st >> 1) * 16 + swz / 64; C = (st & 1) * 32 + (swz % 64) / 2; }
__host__ __device__ __forceinline__ int perm32(int rho) { const int n = rho >> 4, i = rho & 15; return 8 * (i >> 2) + 4 * n + (i & 3); }
struct Unit { int pm, pn; };
struct Gemm { const bf16_t* A; const bf16_t* Bt; int M, N, K, lda, ldb; };
struct StaticOrder {
    int nM, nN, nwg, G, c;
    __device__ void init(int M, int N, int G_, int c_) { nM = M / BM; nN = N / BM; nwg = nM * nN; G = G_; c = c_; }
    __device__ bool next(int i, Unit& u) const {
        const long L = (long)i * G + c; if (L >= nwg) return false;
        int wgid = (int)L; { const int q = nwg / NXCD, r = nwg % NXCD, xcd = wgid % NXCD, off = wgid / NXCD; wgid = (xcd < r ? xcd * (q + 1) : r * (q + 1) + (xcd - r) * q) + off; }
        const int nig = WGM * nN, gid = wgid / nig, fm = gid * WGM, gsz = (nM - fm) < WGM ? (nM - fm) : WGM;
        u.pm = fm + ((wgid % nig) % gsz); u.pn = (wgid % nig) / gsz; return true;
    }
};

struct EpiProj {
    bf16_t* O; int ldc; const float* ssq_in; float* ssq_v; int vcol0;
    __device__ __forceinline__ void operator()(const f32x4 (&acc)[2][2][4][2], const Unit& u, int wr, int wc, int fr, int fq) const {
        const int row0 = u.pm * BM + wr * 64 + fr, col0 = u.pn * BM + wc * 32 + 8 * fq;
        const bool dov = (ssq_v != nullptr) && (u.pn * BM >= vcol0);
#pragma unroll
        for (int ai = 0; ai < 2; ++ai)
#pragma unroll
            for (int m = 0; m < 4; ++m) {
                const int row = row0 + ai * HALF + m * 16;
#if defined(DBG_NORS)
                const float rs = 1.0f;
#else
                const float rs = rstd_of(row_ssq16(ssq_in, row, fq), 1.0f / DM);
#endif
                float sq = 0.f;
#pragma unroll
                for (int bj = 0; bj < 2; ++bj) { const f32x4 v0 = acc[ai][bj][m][0] * rs, v1 = acc[ai][bj][m][1] * rs;
                    u32x4 w; w.x = cvt_pk_bf16(v0[0], v0[1]); w.y = cvt_pk_bf16(v0[2], v0[3]); w.z = cvt_pk_bf16(v1[0], v1[1]); w.w = cvt_pk_bf16(v1[2], v1[3]);
                    *(u32x4*)(O + (size_t)row * ldc + col0 + bj * HALF) = w;
                    sq += (v0[0] * v0[0] + v0[1] * v0[1]) + (v0[2] * v0[2] + v0[3] * v0[3]) + (v1[0] * v1[0] + v1[1] * v1[1]) + (v1[2] * v1[2] + v1[3] * v1[3]); }
                if (dov) { sq += __shfl_xor(sq, 16); sq += __shfl_xor(sq, 32); if (fq == 0) ssq_v[((size_t)(u.pn - vcol0 / BM) * MT + row) * 4 + wc] = sq; }
            }
    }
};
struct EpiGlu {
    bf16_t* O; int ldc; const bf16_t* Z; int ldz; const float* bias;
    __device__ __forceinline__ void operator()(const f32x4 (&acc)[2][2][4][2], const Unit& u, int wr, int wc, int fr, int fq) const {
        const int row0 = u.pm * BM + wr * 64 + fr, col0 = u.pn * BM + wc * 32 + 8 * fq;
        f32x4 bv[2][2];
#pragma unroll
        for (int bj = 0; bj < 2; ++bj)
#pragma unroll
            for (int n = 0; n < 2; ++n) bv[bj][n] = *(const f32x4*)(bias + col0 + bj * HALF + 4 * n);
#pragma unroll
        for (int ai = 0; ai < 2; ++ai)
#pragma unroll
            for (int m = 0; m < 4; ++m) {
                const int row = row0 + ai * HALF + m * 16;
#pragma unroll
                for (int bj = 0; bj < 2; ++bj) { const u32x4 z = *(const u32x4*)(Z + (size_t)row * ldz + col0 + bj * HALF);
                    const f32x4 g0 = acc[ai][bj][m][0] + bv[bj][0], g1 = acc[ai][bj][m][1] + bv[bj][1];
                    u32x4 w;
                    w.x = cvt_pk_bf16(bf_lo(z.x) * sigmoidf_(g0[0]), bf_hi(z.x) * sigmoidf_(g0[1])); w.y = cvt_pk_bf16(bf_lo(z.y) * sigmoidf_(g0[2]), bf_hi(z.y) * sigmoidf_(g0[3]));
                    w.z = cvt_pk_bf16(bf_lo(z.z) * sigmoidf_(g1[0]), bf_hi(z.z) * sigmoidf_(g1[1])); w.w = cvt_pk_bf16(bf_lo(z.w) * sigmoidf_(g1[2]), bf_hi(z.w) * sigmoidf_(g1[3]));
                    *(u32x4*)(O + (size_t)row * ldc + col0 + bj * HALF) = w; }
            }
    }
};
struct EpiResid {
    float* H; bf16_t* HB; float* ssq_out; const float* xp; const float* xs;
    __device__ __forceinline__ void operator()(const f32x4 (&acc)[2][2][4][2], const Unit& u, int wr, int wc, int fr, int fq) const {
        const int row0 = u.pm * BM + wr * 64 + fr, col0 = u.pn * BM + wc * 32 + 8 * fq;
#pragma unroll
        for (int ai = 0; ai < 2; ++ai)
#pragma unroll
            for (int m = 0; m < 4; ++m) {
                const int row = row0 + ai * HALF + m * 16; float sq = 0.f;
#pragma unroll
                for (int bj = 0; bj < 2; ++bj) { float* hp = H + (size_t)row * DM + col0 + bj * HALF;
                    const float* bp = xp ? (row < MP ? xp + (size_t)row * DM : xs + (size_t)(row - MP) * DM) + col0 + bj * HALF : hp;
                    const f32x4 v0 = *(const f32x4*)bp + acc[ai][bj][m][0], v1 = *(const f32x4*)(bp + 4) + acc[ai][bj][m][1];
                    *(f32x4*)hp = v0; *(f32x4*)(hp + 4) = v1;
                    u32x4 w; w.x = cvt_pk_bf16(v0[0], v0[1]); w.y = cvt_pk_bf16(v0[2], v0[3]); w.z = cvt_pk_bf16(v1[0], v1[1]); w.w = cvt_pk_bf16(v1[2], v1[3]);
                    *(u32x4*)(HB + (size_t)row * DM + col0 + bj * HALF) = w;
                    sq += (v0[0] * v0[0] + v0[1] * v0[1]) + (v0[2] * v0[2] + v0[3] * v0[3]) + (v1[0] * v1[0] + v1[1] * v1[1]) + (v1[2] * v1[2] + v1[3] * v1[3]); }
                sq += __shfl_xor(sq, 16); sq += __shfl_xor(sq, 32); if (fq == 0) ssq_out[((size_t)u.pn * MT + row) * 4 + wc] = sq;
                if (m & 1) asm volatile("" ::: "memory");
            }
    }
};
struct EpiSwiglu {
    bf16_t* O; const float* ssq_in;
    __device__ __forceinline__ void operator()(const f32x4 (&acc)[2][2][4][2], const Unit& u, int wr, int wc, int fr, int fq) const {
        const int row0 = u.pm * BM + wr * 64 + fr, col0 = u.pn * HALF + wc * 32 + 8 * fq;
#pragma unroll
        for (int ai = 0; ai < 2; ++ai)
#pragma unroll
            for (int m = 0; m < 4; ++m) {
                const int row = row0 + ai * HALF + m * 16; const float rs = rstd_of(row_ssq16(ssq_in, row, fq), 1.0f / DM);
                const f32x4 g0 = acc[ai][0][m][0] * rs, g1 = acc[ai][0][m][1] * rs, u0 = acc[ai][1][m][0] * rs, u1 = acc[ai][1][m][1] * rs;
                u32x4 w;
                w.x = cvt_pk_bf16(g0[0] * sigmoidf_(g0[0]) * u0[0], g0[1] * sigmoidf_(g0[1]) * u0[1]); w.y = cvt_pk_bf16(g0[2] * sigmoidf_(g0[2]) * u0[2], g0[3] * sigmoidf_(g0[3]) * u0[3]);
                w.z = cvt_pk_bf16(g1[0] * sigmoidf_(g1[0]) * u1[0], g1[1] * sigmoidf_(g1[1]) * u1[1]); w.w = cvt_pk_bf16(g1[2] * sigmoidf_(g1[2]) * u1[2], g1[3] * sigmoidf_(g1[3]) * u1[3]);
                *(u32x4*)(O + (size_t)row * FF + col0) = w;
            }
    }
};

struct OneUnit { Unit u; __device__ bool next(int i, Unit& o) const { if (i != 0) return false; o = u; return true; } };
template <class Epi, bool ALIGN_EPI = true, class Sched = StaticOrder>
__device__ __forceinline__ void gemm_phase(LAS unsigned char* lds, const Gemm g, const Sched& S, const Epi& E) {
    const int tid = launder_v(threadIdx.x), wid = __builtin_amdgcn_readfirstlane(tid >> 6), lane = tid & 63, wr = wid >> 2, wc = wid & 3, fr = lane & 15, fq = lane >> 4;
    const int K = g.K, nt = K / BK;
    unsigned voffA[2], voffB[2];
#pragma unroll
    for (int i = 0; i < 2; ++i) { int R, C; stage_rc(tid * 16 + i * 8192, R, C); const int Rb = (R & ~31) + perm32(R & 31);
        voffA[i] = (unsigned)(R * g.lda + C) * 2u; voffB[i] = (unsigned)(Rb * g.ldb + C) * 2u; }
    const size_t kstep = (size_t)(BK * 2);
    const size_t hstepA = (size_t)HALF * g.lda * 2, hstepB = (size_t)HALF * g.ldb * 2;
    const size_t tstepA = 2 * hstepA, tstepB = 2 * hstepB;
    const unsigned ldsw = (unsigned)wid * 1024u;
    const int aoff = lds_byte(wr * 64 + fr, fq * 8), boff = lds_byte(wc * 32 + fr, fq * 8);
#define PG8_SA(b, h) (((b) * 2 + (h)) * HTB)
#define PG8_SB(b, h) ((4 + (b) * 2 + (h)) * HTB)
#define PG8_STAGE(bufoff, gbase, voff) do { _Pragma("unroll") for (int _i = 0; _i < 2; ++_i) \
        __builtin_amdgcn_global_load_lds((const unsigned*)((const char*)(gbase) + (voff)[_i]), (LAS unsigned*)(lds + (bufoff) + ldsw + _i * 8192), 16, 0, 0); } while (0)
#define PG8_LDA(dst, b, h) do { _Pragma("unroll") for (int m = 0; m < 4; ++m) _Pragma("unroll") for (int k = 0; k < 2; ++k) dst[m][k] = *(const LAS bf16x8*)(lds + PG8_SA(b, h) + aoff + m * 2048 + k * 1024); } while (0)
#define PG8_LDB(dst, b, h) do { _Pragma("unroll") for (int n = 0; n < 2; ++n) _Pragma("unroll") for (int k = 0; k < 2; ++k) dst[n][k] = *(const LAS bf16x8*)(lds + PG8_SB(b, h) + boff + n * 2048 + k * 1024); } while (0)
#define PG8_MMA(ai, bj, At, Bt) do { __builtin_amdgcn_s_setprio(1); _Pragma("unroll") for (int m = 0; m < 4; ++m) _Pragma("unroll") for (int n = 0; n < 2; ++n) _Pragma("unroll") for (int k = 0; k < 2; ++k) \
        acc[ai][bj][m][n] = __builtin_amdgcn_mfma_f32_16x16x32_bf16(Bt[n][k], At[m][k], acc[ai][bj][m][n], 0, 0, 0); __builtin_amdgcn_s_setprio(0); } while (0)
#define PG8_WAIT_V(n) asm volatile("s_waitcnt vmcnt(" #n ")" ::: "memory")
#define PG8_WAIT_L(n) asm volatile("s_waitcnt lgkmcnt(" #n ")" ::: "memory")
#define PG8_BAR __builtin_amdgcn_s_barrier()
#define PG8_SCHED __builtin_amdgcn_sched_barrier(0)
    Unit cur, nxt; int ui = 0;
    if (!S.next(0, cur)) return;
    f32x4 acc[2][2][4][2];
#pragma unroll
    for (int a = 0; a < 2; ++a)
#pragma unroll
        for (int b = 0; b < 2; ++b)
#pragma unroll
            for (int m = 0; m < 4; ++m)
#pragma unroll
                for (int n = 0; n < 2; ++n) acc[a][b][m][n] = (f32x4){0.f, 0.f, 0.f, 0.f};
    bf16x8 At[4][2], B0[2][2], B1[2][2];
    const char* cA = (const char*)g.A + (size_t)cur.pm * tstepA; const char* cB = (const char*)g.Bt + (size_t)cur.pn * tstepB;
    PG8_STAGE(PG8_SB(0, 0), cB, voffB); PG8_STAGE(PG8_SB(0, 1), cB + hstepB, voffB); PG8_STAGE(PG8_SA(0, 0), cA, voffA); PG8_STAGE(PG8_SA(0, 1), cA + hstepA, voffA);
    if (wr == 1) PG8_BAR;
    PG8_WAIT_V(2); PG8_BAR;
    PG8_STAGE(PG8_SB(1, 0), cB + kstep, voffB); PG8_STAGE(PG8_SA(1, 0), cA + kstep, voffA); PG8_STAGE(PG8_SB(1, 1), cB + hstepB + kstep, voffB);
    PG8_WAIT_V(6); PG8_BAR;
    for (;;) {
        const bool has_next = S.next(ui + 1, nxt);
        const char* nA = has_next ? (const char*)g.A + (size_t)nxt.pm * tstepA : cA; const char* nB = has_next ? (const char*)g.Bt + (size_t)nxt.pn * tstepB : cB;
        for (int t = 0; t < nt; t += 2) {
            const bool last = (t == nt - 2);
            const char* a1 = cA + (size_t)(t + 1) * kstep;
            const char* a2 = last ? nA : cA + (size_t)(t + 2) * kstep; const char* b2 = last ? nB : cB + (size_t)(t + 2) * kstep;
            const char* a3 = a2 + kstep; const char* b3 = b2 + kstep;
            PG8_LDB(B0, 0, 0); PG8_LDB(B1, 0, 1); PG8_SCHED; PG8_LDA(At, 0, 0); PG8_STAGE(PG8_SA(1, 1), a1 + hstepA, voffA);
            PG8_WAIT_V(8); PG8_WAIT_L(0); PG8_BAR; PG8_MMA(0, 0, At, B0); PG8_MMA(0, 1, At, B1); PG8_BAR; PG8_SCHED;
            PG8_LDA(At, 0, 1); PG8_STAGE(PG8_SB(0, 0), b2, voffB); PG8_STAGE(PG8_SB(0, 1), b2 + hstepB, voffB); PG8_STAGE(PG8_SA(0, 0), a2, voffA);
            PG8_WAIT_V(8); PG8_WAIT_L(0); PG8_BAR; PG8_MMA(1, 0, At, B0); PG8_MMA(1, 1, At, B1); PG8_BAR; PG8_SCHED;
            PG8_LDB(B0, 1, 0); PG8_LDB(B1, 1, 1); PG8_SCHED; PG8_LDA(At, 1, 0); PG8_STAGE(PG8_SA(0, 1), a2 + hstepA, voffA);
            PG8_WAIT_V(8); PG8_WAIT_L(0); PG8_BAR; PG8_MMA(0, 0, At, B0); PG8_MMA(0, 1, At, B1); PG8_BAR; PG8_SCHED;
            PG8_LDA(At, 1, 1); PG8_STAGE(PG8_SB(1, 0), b3, voffB); PG8_STAGE(PG8_SB(1, 1), b3 + hstepB, voffB); PG8_STAGE(PG8_SA(1, 0), a3, voffA);
            PG8_WAIT_V(8); PG8_WAIT_L(0); PG8_BAR; PG8_MMA(1, 0, At, B0); PG8_MMA(1, 1, At, B1); PG8_BAR; PG8_SCHED;
        }
        if constexpr (ALIGN_EPI) { if (wr == 0) PG8_BAR; }
        E(acc, cur, wr, wc, fr, fq);
        if (!has_next) break;
#pragma unroll
        for (int a = 0; a < 2; ++a)
#pragma unroll
            for (int b = 0; b < 2; ++b)
#pragma unroll
                for (int m = 0; m < 4; ++m)
#pragma unroll
                    for (int n = 0; n < 2; ++n) acc[a][b][m][n] = (f32x4){0.f, 0.f, 0.f, 0.f};
        cur = nxt; cA = nA; cB = nB; ++ui;
        if constexpr (ALIGN_EPI) { if (wr == 1) PG8_BAR; }
    }
    PG8_WAIT_V(0);
    if constexpr (!ALIGN_EPI) { if (wr == 0) PG8_BAR; }
    PG8_BAR;
#undef PG8_SA
#undef PG8_SB
#undef PG8_STAGE
#undef PG8_LDA
#undef PG8_LDB
#undef PG8_MMA
#undef PG8_WAIT_V
#undef PG8_WAIT_L
#undef PG8_BAR
#undef PG8_SCHED
}

template <class Epi>
__device__ __forceinline__ void gemm_unit_rs(LAS unsigned char* lds, const Gemm g, const Unit cur, const Epi& E) {
    const int tid = launder_v(threadIdx.x), wid = __builtin_amdgcn_readfirstlane(tid >> 6), lane = tid & 63, wr = wid >> 2, wc = wid & 3, fr = lane & 15, fq = lane >> 4;
    const int nt = g.K / BK;
    unsigned voffA[2], voffB[2];
#pragma unroll
    for (int i = 0; i < 2; ++i) { int R, C; stage_rc(tid * 16 + i * 8192, R, C); const int Rb = (R & ~31) + perm32(R & 31);
        voffA[i] = (unsigned)(R * g.lda + C) * 2u; voffB[i] = (unsigned)(Rb * g.ldb + C) * 2u; }
    const size_t hstepA = (size_t)HALF * g.lda * 2, hstepB = (size_t)HALF * g.ldb * 2;
    const char* cA = (const char*)g.A + (size_t)cur.pm * 2 * hstepA; const char* cB = (const char*)g.Bt + (size_t)cur.pn * 2 * hstepB;
    const int aoff = lds_byte(wr * 64 + fr, fq * 8), boff = lds_byte(wc * 32 + fr, fq * 8);
    const unsigned wofs = (unsigned)tid * 16u;
    f32x4 acc[2][2][4][2];
#pragma unroll
    for (int a = 0; a < 2; ++a)
#pragma unroll
        for (int b = 0; b < 2; ++b)
#pragma unroll
            for (int m = 0; m < 4; ++m)
#pragma unroll
                for (int n = 0; n < 2; ++n) acc[a][b][m][n] = (f32x4){0.f, 0.f, 0.f, 0.f};
    u32x4 st[8];
#define RS_LOAD(kt) do { const char* a_ = cA + (size_t)(kt) * (BK * 2); const char* b_ = cB + (size_t)(kt) * (BK * 2); \
        _Pragma("unroll") for (int h = 0; h < 2; ++h) _Pragma("unroll") for (int i = 0; i < 2; ++i) { \
            st[h * 2 + i] = *(const u32x4*)(a_ + h * hstepA + voffA[i]); st[4 + h * 2 + i] = *(const u32x4*)(b_ + h * hstepB + voffB[i]); } } while (0)
#define RS_STORE(buf) do { _Pragma("unroll") for (int h = 0; h < 2; ++h) _Pragma("unroll") for (int i = 0; i < 2; ++i) { \
            *(LAS u32x4*)(lds + ((buf) * 2 + h) * HTB + i * 8192 + wofs) = st[h * 2 + i]; *(LAS u32x4*)(lds + (4 + (buf) * 2 + h) * HTB + i * 8192 + wofs) = st[4 + h * 2 + i]; } } while (0)
    RS_LOAD(0); RS_STORE(0); __syncthreads();
    for (int kt = 0; kt < nt; ++kt) {
        const int b = kt & 1;
        if (kt + 1 < nt) RS_LOAD(kt + 1);
        __builtin_amdgcn_sched_barrier(0);
        bf16x8 B0[2][2], B1[2][2], At[4][2];
#pragma unroll
        for (int n = 0; n < 2; ++n)
#pragma unroll
            for (int k = 0; k < 2; ++k) { B0[n][k] = *(const LAS bf16x8*)(lds + (4 + b * 2 + 0) * HTB + boff + n * 2048 + k * 1024); B1[n][k] = *(const LAS bf16x8*)(lds + (4 + b * 2 + 1) * HTB + boff + n * 2048 + k * 1024); }
#pragma unroll
        for (int ai = 0; ai < 2; ++ai) {
#pragma unroll
            for (int m = 0; m < 4; ++m)
#pragma unroll
                for (int k = 0; k < 2; ++k) At[m][k] = *(const LAS bf16x8*)(lds + (b * 2 + ai) * HTB + aoff + m * 2048 + k * 1024);
#pragma unroll
            for (int m = 0; m < 4; ++m)
#pragma unroll
                for (int n = 0; n < 2; ++n)
#pragma unroll
                    for (int k = 0; k < 2; ++k) { acc[ai][0][m][n] = __builtin_amdgcn_mfma_f32_16x16x32_bf16(B0[n][k], At[m][k], acc[ai][0][m][n], 0, 0, 0);
                                                  acc[ai][1][m][n] = __builtin_amdgcn_mfma_f32_16x16x32_bf16(B1[n][k], At[m][k], acc[ai][1][m][n], 0, 0, 0); }
        }
        __builtin_amdgcn_sched_barrier(0);
        if (kt + 1 < nt) RS_STORE(b ^ 1);
        __syncthreads();
    }
#undef RS_LOAD
#undef RS_STORE
    E(acc, cur, wr, wc, fr, fq);
}
}

__device__ __forceinline__ float wave_sum(float v) {
#pragma unroll
    for (int o = 1; o < 64; o <<= 1) v += __shfl_xor(v, o);
    return v;
}
__device__ __forceinline__ void xpose_mat(const float* __restrict__ W, int ldw, int K, int N, bf16_t* dst, int ldt, int dcol0, const float* __restrict__ gain, int mapmode,
                                          LAS float* scr, int gw, int NGW, int lane) {
    const int nblk = N / 32, nit = (K / 64) * nblk;
    for (int it = gw; it < nit; it += NGW) {
        const int kb = it / nblk, nb = it % nblk, k0 = 64 * kb, n0 = 32 * nb;
        float wv[32];
#pragma unroll
        for (int i = 0; i < 32; ++i) wv[i] = W[(size_t)(k0 + 2 * i + (lane >> 5)) * ldw + n0 + (lane & 31)];
#pragma unroll
        for (int i = 0; i < 32; ++i) { const int kk = 2 * i + (lane >> 5); float w = wv[i]; if (gain) w *= gain[k0 + kk]; scr[kk * 33 + (lane & 31)] = w; }
        LDS_WAIT();
        const int c = lane & 7;
#pragma unroll
        for (int j = 0; j < 4; ++j) { const int n = (lane >> 3) + 8 * j; const LAS float* s = scr + (8 * c) * 33 + n;
            u32x4 o; o.x = cvt_pk_bf16(s[0 * 33], s[1 * 33]); o.y = cvt_pk_bf16(s[2 * 33], s[3 * 33]); o.z = cvt_pk_bf16(s[4 * 33], s[5 * 33]); o.w = cvt_pk_bf16(s[6 * 33], s[7 * 33]);
            const int nn = n0 + n; const int row = mapmode == 0 ? nn : (256 * (nn >> 7) + (nn & 127) + (mapmode == 2 ? 128 : 0));
            *(u32x4*)(dst + (size_t)row * ldt + dcol0 + k0 + 8 * c) = o; }
        LDS_WAIT();
    }
}
__device__ __forceinline__ void sincos_d(double x, double& s, double& c) {
    const double q = __builtin_rint(x * 0.63661977236758134308), r = (x - q * 1.57079632679489655800) - q * 6.12323399573676603587e-17;
    const double r2 = r * r;
    double sp = r * (1.0 + r2 * (-1.0 / 6 + r2 * (1.0 / 120 + r2 * (-1.0 / 5040 + r2 * (1.0 / 362880 + r2 * (-1.0 / 39916800 + r2 * (1.0 / 6227020800.0)))))));
    double cp = 1.0 + r2 * (-0.5 + r2 * (1.0 / 24 + r2 * (-1.0 / 720 + r2 * (1.0 / 40320 + r2 * (-1.0 / 3628800 + r2 * (1.0 / 479001600 + r2 * (-1.0 / 87178291200.0)))))));
    const int qi = ((int)q) & 3;
    s = (qi == 0) ? sp : (qi == 1) ? cp : (qi == 2) ? -sp : -cp;
    c = (qi == 0) ? cp : (qi == 1) ? -sp : (qi == 2) ? -cp : sp;
}

struct Args { const float* in[33]; float* out; unsigned char* ws; int ph_lo, ph_hi; };

struct S5Ctx { const bf16_t* PROJ; bf16_t* PROJw; const f32x2* Atab; const f32x2* A128; const bf16_t* Bbar; const bf16_t* Ctab; const float* Dsk; f32x2* Sloc; const f32x2* Car;
               const float* st_re; const float* st_im; float* p_re; float* p_im; float* s_re; float* s_im; };

template <bool PASSB>
__device__ __forceinline__ void s5_unit(const S5Ctx& S, LAS float* X, int lane, int m0, int g, bool sample, int b, int c) {
    const int l31 = lane & 31, lh = lane >> 5, l15 = lane & 15, lq = lane >> 4;
    bf16x8 Bf[4];
#pragma unroll
    for (int sb = 0; sb < 4; ++sb) Bf[sb] = *(const bf16x8*)(S.Bbar + ((g * 128 + 32 * sb + l31) * 16 + 8 * lh));
    const f32x2 a = {((const float*)S.Atab)[g * 64 + lane], ((const float*)S.Atab)[4096 + g * 64 + lane]};
    bf16x8 Cf[4]; f32x4 Dv = (f32x4){0.f, 0.f, 0.f, 0.f};
    if (PASSB) {
#pragma unroll
        for (int ks = 0; ks < 4; ++ks) Cf[ks] = *(const bf16x8*)(S.Ctab + ((g * 16 + l15) * 128 + 32 * ks + 8 * lq));
        Dv = *(const f32x4*)(S.Dsk + g * 16 + 4 * lq);
    }
    float hr = 0.f, hi = 0.f;
    if (PASSB && !sample && c > 0) {
        const float a128x = ((const float*)S.A128)[g * 64 + lane], a128y = ((const float*)S.A128)[4096 + g * 64 + lane];
        const float* sp = (const float*)S.Sloc + (size_t)(b * 16) * 2048 + g * 64 + lane;
        for (int j = 0; j < c; ++j) { const float svx = sp[(size_t)j * 2048], svy = sp[262144 + (size_t)j * 2048];
            const float nr = a128x * hr - a128y * hi + svx; hi = a128x * hi + a128y * hr + svy; hr = nr; }
    }
    for (int tb = 0; tb < 4; ++tb) {
        const bf16x8 Af = *(const bf16x8*)(S.PROJ + (size_t)(m0 + 32 * tb + l31) * PLD + g * 16 + 8 * lh);
#pragma unroll
        for (int sb = 0; sb < 4; ++sb) {
            f32x16 acc;
#pragma unroll
            for (int r = 0; r < 16; ++r) acc[r] = 0.f;
            acc = __builtin_amdgcn_mfma_f32_32x32x16_bf16(Af, Bf[sb], acc, 0, 0, 0);
#pragma unroll
            for (int r = 0; r < 16; ++r) X[(8 * (r >> 2) + 4 * lh + (r & 3)) * 132 + 32 * sb + l31] = acc[r];
        }
        LDS_WAIT();
#pragma unroll 8
        for (int t = 0; t < 32; ++t) {
            if (sample && (t & 3) == 0) { const int bi = b + ((32 * tb + t) >> 2); hr = S.st_re[(size_t)(bi * 32 + g) * 64 + lane]; hi = S.st_im[(size_t)(bi * 32 + g) * 64 + lane]; }
            const float xr = X[t * 132 + lane], xi = X[t * 132 + 64 + lane];
            const float nr = a.x * hr - a.y * hi + xr, ni = a.x * hi + a.y * hr + xi; hr = nr; hi = ni;
            if (PASSB) { X[t * 132 + lane] = hr; X[t * 132 + 64 + lane] = hi; }
            if (PASSB && sample && (t & 3) == 3) { const int bi = b + ((32 * tb + t) >> 2); S.s_re[(size_t)(bi * 32 + g) * 64 + lane] = hr; S.s_im[(size_t)(bi * 32 + g) * 64 + lane] = hi; }
        }
        LDS_WAIT();
        if (PASSB) {
#pragma unroll
            for (int tb2 = 0; tb2 < 2; ++tb2) {
                f32x4 acc = (f32x4){0.f, 0.f, 0.f, 0.f};
#pragma unroll
                for (int ks = 0; ks < 4; ++ks) { const LAS float* hp = X + (16 * tb2 + l15) * 132 + 32 * ks + 8 * lq;
                    const f32x4 h0 = *(const LAS f32x4*)hp, h1 = *(const LAS f32x4*)(hp + 4);
                    u32x4 hw; hw.x = cvt_pk_bf16(h0[0], h0[1]); hw.y = cvt_pk_bf16(h0[2], h0[3]); hw.z = cvt_pk_bf16(h1[0], h1[1]); hw.w = cvt_pk_bf16(h1[2], h1[3]);
                    acc = __builtin_amdgcn_mfma_f32_16x16x32_bf16(Cf[ks], __builtin_bit_cast(bf16x8, hw), acc, 0, 0, 0); }
                const size_t m = (size_t)(m0 + 32 * tb + 16 * tb2 + l15);
                const u32x2 uu = *(const u32x2*)(S.PROJ + m * PLD + g * 16 + 4 * lq);
                float y[4]; y[0] = acc[0] + Dv[0] * bf_lo(uu.x); y[1] = acc[1] + Dv[1] * bf_hi(uu.x); y[2] = acc[2] + Dv[2] * bf_lo(uu.y); y[3] = acc[3] + Dv[3] * bf_hi(uu.y);
#pragma unroll
                for (int r = 0; r < 4; ++r) y[r] = y[r] * sigmoidf_(1.5957691216057308f * (y[r] + 0.044715f * y[r] * y[r] * y[r]));
                u32x2 zw; zw.x = cvt_pk_bf16(y[0], y[1]); zw.y = cvt_pk_bf16(y[2], y[3]);
                *(u32x2*)(S.PROJw + m * PLD + 1536 + g * 16 + 4 * lq) = zw;
            }
            LDS_WAIT();
        }
    }
    if (!PASSB) { float* sp = (float*)S.Sloc + (size_t)((b * 16 + c) * 32 + g) * 64 + lane; sp[0] = hr; sp[262144] = hi; }
    if (PASSB && !sample && c == 15) { S.p_re[(size_t)(b * 32 + g) * 64 + lane] = hr; S.p_im[(size_t)(b * 32 + g) * 64 + lane] = hi; }
}

struct SguCtx { const bf16_t* PROJ; bf16_t* MIX; const float* ssqv; const float* gnorm; const bf16_t* Wm; const float* sgu_w; const float* sgu_b; float* s_v; };

__device__ __forceinline__ void sgu_unit(const SguCtx& S, LAS bf16_t* VT, int lane, int m0, int hd) {
    const int l15 = lane & 15, lq = lane >> 4;
#pragma unroll
    for (int jj = 0; jj < 2; ++jj) {
        const int j = lane + 64 * jj; const size_t m = (size_t)(m0 + j); const f32x4 q0 = *(const f32x4*)(S.ssqv + m * 4), q1 = *(const f32x4*)(S.ssqv + ((size_t)MT + m) * 4); const float rs = rstd_of(((q0[0] + q0[1]) + (q0[2] + q0[3])) + ((q1[0] + q1[1]) + (q1[2] + q1[3])), 1.0f / 512);
#pragma unroll
        for (int d8 = 0; d8 < 8; ++d8) {
            const u32x4 v = *(const u32x4*)(S.PROJ + m * PLD + 1024 + hd * 64 + 8 * d8);
            const f32x4 g0 = *(const f32x4*)(S.gnorm + hd * 64 + 8 * d8), g1 = *(const f32x4*)(S.gnorm + hd * 64 + 8 * d8 + 4);
            LAS bf16_t* p = VT + (8 * d8) * 136 + j;
            p[0 * 136] = f2bf(bf_lo(v.x) * rs * g0[0]); p[1 * 136] = f2bf(bf_hi(v.x) * rs * g0[1]); p[2 * 136] = f2bf(bf_lo(v.y) * rs * g0[2]); p[3 * 136] = f2bf(bf_hi(v.y) * rs * g0[3]);
            p[4 * 136] = f2bf(bf_lo(v.z) * rs * g1[0]); p[5 * 136] = f2bf(bf_hi(v.z) * rs * g1[1]); p[6 * 136] = f2bf(bf_lo(v.w) * rs * g1[2]); p[7 * 136] = f2bf(bf_hi(v.w) * rs * g1[3]);
        }
    }
    LDS_WAIT();
    for (int ib = 0; ib < 8; ++ib) {
        const int nks = (ib >> 1) + 1;
        bf16x8 Bw[4];
#pragma unroll
        for (int ks = 0; ks < 4; ++ks) if (ks < nks) Bw[ks] = *(const bf16x8*)(S.Wm + (size_t)((hd * 128 + 16 * ib + l15) * 128 + 32 * ks + 8 * lq));
        const int i = 16 * ib + l15; const size_t m = (size_t)(m0 + i); const float bias = S.sgu_b[hd * 128 + i];
#pragma unroll
        for (int db = 0; db < 4; ++db) {
            f32x4 acc = (f32x4){0.f, 0.f, 0.f, 0.f};
#pragma unroll
            for (int ks = 0; ks < 4; ++ks) if (ks < nks) {
                const bf16x8 Av = *(const LAS bf16x8*)(VT + (16 * db + l15) * 136 + 32 * ks + 8 * lq);
                acc = __builtin_amdgcn_mfma_f32_16x16x32_bf16(Av, Bw[ks], acc, 0, 0, 0);
            }
            const int col = hd * 64 + 16 * db + 4 * lq;
            const u32x2 uu = *(const u32x2*)(S.PROJ + m * PLD + 512 + col);
            u32x2 w; w.x = cvt_pk_bf16(bf_lo(uu.x) * (acc[0] + bias), bf_hi(uu.x) * (acc[1] + bias)); w.y = cvt_pk_bf16(bf_lo(uu.y) * (acc[2] + bias), bf_hi(uu.y) * (acc[3] + bias));
            *(u32x2*)(S.MIX + m * DM + 512 + col) = w;
        }
    }
    LDS_WAIT();
}

#define MAKE_SC S5Ctx SC{PROJ, PROJ, (const f32x2*)((const float*)(ws + WS_ATAB) + i * 2048), (const f32x2*)((const float*)(ws + WS_A128) + i * 2048), (const bf16_t*)(ws + WS_BBAR) + (size_t)i * 32 * 128 * 16, (const bf16_t*)(ws + WS_CTAB) + (size_t)i * 32 * 16 * 128, args.in[18] + i * 512, (f32x2*)(ws + WS_SLOC), (const f32x2*)(ws + WS_CAR), args.in[2] + (size_t)i * 128 * 2048, args.in[3] + (size_t)i * 128 * 2048, args.out + O_PRE + (size_t)i * 8 * 2048, args.out + O_PIM + (size_t)i * 8 * 2048, args.out + O_SRE + (size_t)i * 128 * 2048, args.out + O_SIM + (size_t)i * 128 * 2048};
#define MAKE_GC SguCtx GC{PROJ, MIX, ssqv + (size_t)i * MT * 8, args.in[21] + i * 512, (const bf16_t*)(ws + WS_WM) + (size_t)i * 8 * 128 * 128, args.in[22] + (size_t)i * 8 * 128 * 128, args.in[23] + i * 1024, args.out + O_SV + (size_t)i * 128 * 4 * 512};
#define RUN_GEMM(EPI) pg8::gemm_phase<EPI, true, pg8::StaticOrder>(lds, g, S, E)
__device__ __forceinline__ void own_grid_barrier(unsigned* cnt, unsigned target) {
    asm volatile("s_waitcnt vmcnt(0) lgkmcnt(0)" ::: "memory");
    __syncthreads();
    if (threadIdx.x == 0) {
        __builtin_amdgcn_fence(__ATOMIC_RELEASE, "agent"); asm volatile("s_waitcnt vmcnt(0)" ::: "memory");
        __hip_atomic_fetch_add(cnt, 1u, __ATOMIC_RELAXED, __HIP_MEMORY_SCOPE_AGENT);
        unsigned spins = 0;
        while (__hip_atomic_load(cnt, __ATOMIC_RELAXED, __HIP_MEMORY_SCOPE_AGENT) < target) { __builtin_amdgcn_s_sleep(1); if (++spins > (1u << 26)) break; }
    }
    __syncthreads();
    __builtin_amdgcn_fence(__ATOMIC_ACQUIRE, "agent");
}
__global__ void __launch_bounds__(512, 2) fwd_megakernel(Args args) {
    extern __shared__ __attribute__((aligned(16))) unsigned char lds_raw[];
    LAS unsigned char* lds = (LAS unsigned char*)lds_raw;
    cg::grid_group grid = cg::this_grid();
    const int G = gridDim.x, bx = blockIdx.x, NGW = G * 8, NGT = G * 512;
    const int lo = args.ph_lo, hi = args.ph_hi; int pidx = 0; int nbar = 0;
#define PH_BEGIN if (pidx >= lo && pidx < hi) { \
    const int tid = launder_v(threadIdx.x), lane = tid & 63, wave = __builtin_amdgcn_readfirstlane(tid >> 6); \
    const int gw = bx * 8 + wave, gt = bx * 512 + tid; (void)gw; (void)gt; (void)lane; \
    const size_t lz_ = launder_zero(); unsigned char* ws = args.ws + lz_; float* H = args.out + lz_; \
    float* ssq = (float*)(ws + WS_SSQ); float* ssqv = (float*)(ws + WS_SSQV); (void)ssqv; bf16_t* HB = (bf16_t*)(ws + WS_HB); bf16_t* PROJ = (bf16_t*)(ws + WS_PROJ); bf16_t* MIX = (bf16_t*)(ws + WS_MIX); bf16_t* ACT = (bf16_t*)(ws + WS_ACT); \
    (void)ssq; (void)HB; (void)PROJ; (void)MIX; (void)ACT; (void)H; \
    LAS unsigned char* wreg = lds + wave * WREG; (void)wreg;
#define PH_END } if (pidx >= lo && pidx + 1 < hi) { own_grid_barrier((unsigned*)(args.ws + WS_BAR), (unsigned)(++nbar) * (unsigned)G); } ++pidx;

    PH_BEGIN
    {
        LAS float* scr = (LAS float*)wreg;
        for (int i = 0; i < 2; ++i) {
            const int Le = 2 * i, Lo = 2 * i + 1;
            xpose_mat(args.in[9] + (size_t)i * DM * 1536, 1536, DM, 1536, (bf16_t*)(ws + WS_W1E + i * 3 * MiB), DM, 0, args.in[6] + Le * DM, 0, scr, gw, NGW, lane);
            xpose_mat(args.in[10] + (size_t)i * DM * DM, DM, DM, DM, (bf16_t*)(ws + WS_WOE + i * 2 * MiB), DM, 0, nullptr, 0, scr, gw, NGW, lane);
            xpose_mat(args.in[19] + (size_t)i * 512 * 512, 512, 512, 512, (bf16_t*)(ws + WS_GLU + i * (MiB / 2)), 512, 0, nullptr, 0, scr, gw, NGW, lane);
            xpose_mat(args.in[24] + (size_t)i * DM * 2048, 2048, DM, 2048, (bf16_t*)(ws + WS_W1O + i * 4 * MiB), DM, 0, args.in[6] + Lo * DM, 0, scr, gw, NGW, lane);
            xpose_mat(args.in[25] + (size_t)i * DM * DM + (size_t)512 * DM, DM, 512, DM, (bf16_t*)(ws + WS_WOO + i * 2 * MiB), DM, 512, nullptr, 0, scr, gw, NGW, lane);
        }
        for (int L = 0; L < 4; ++L) {
            bf16_t* wgu = (bf16_t*)(ws + WS_WGU + L * 11 * MiB);
            xpose_mat(args.in[30] + (size_t)L * DM * FF, FF, DM, FF, wgu, DM, 0, args.in[7] + L * DM, 1, scr, gw, NGW, lane);
            xpose_mat(args.in[31] + (size_t)L * DM * FF, FF, DM, FF, wgu, DM, 0, args.in[7] + L * DM, 2, scr, gw, NGW, lane);
            xpose_mat(args.in[32] + (size_t)L * FF * DM, DM, FF, DM, (bf16_t*)(ws + WS_WD + L * (11 * MiB / 2)), FF, 0, nullptr, 0, scr, gw, NGW, lane);
        }
        for (int it = gw; it < 2 * 4 * 2 * 128; it += NGW) {
            const int i = it >> 10, g = (it >> 8) & 3, ch = (it >> 7) & 1, n0 = (it & 127) * 8, c = ch * 64 + lane;
            const float* pw = args.in[26] + (size_t)((i * 4 + g) * 128 + c) * 128; const float* sc = args.in[27] + i * 512 + g * 128;
            const float* wo = args.in[25] + (size_t)i * DM * DM + (size_t)(g * 128) * DM + n0;
            float s8[8];
#pragma unroll
            for (int e = 0; e < 8; ++e) s8[e] = 0.f;
            for (int d = 0; d < 128; d += 4) {
                const f32x4 p4 = *(const f32x4*)(pw + d);
#pragma unroll
                for (int dd = 0; dd < 4; ++dd) { const float ps = p4[dd] * sc[d + dd]; const f32x4 w0 = *(const f32x4*)(wo + (size_t)(d + dd) * DM), w1 = *(const f32x4*)(wo + (size_t)(d + dd) * DM + 4);
                    s8[0] += ps * w0[0]; s8[1] += ps * w0[1]; s8[2] += ps * w0[2]; s8[3] += ps * w0[3]; s8[4] += ps * w1[0]; s8[5] += ps * w1[1]; s8[6] += ps * w1[2]; s8[7] += ps * w1[3]; }
            }
            bf16_t* dst = (bf16_t*)(ws + WS_WOO + i * 2 * MiB) + (size_t)n0 * DM + g * 128 + c;
#pragma unroll
            for (int e = 0; e < 8; ++e) dst[(size_t)e * DM] = f2bf(s8[e]);
        }
        for (int it = gt; it < 2 * 32 * 64; it += NGT) {
            const int i = it >> 11, g = (it >> 6) & 31, n = it & 63;
            const float lr = args.in[11][it], li = args.in[12][it], dt = expf(args.in[13][i * 32 + g]);
            const double mag = (double)expf(lr * dt); double sn, cs; sincos_d((double)li * (double)dt, sn, cs);
            const double ar = mag * cs, ai = mag * sn, den = (double)lr * lr + (double)li * li;
            const float fr = (float)(((ar - 1.0) * lr + ai * li) / den), fi = (float)((ai * lr - (ar - 1.0) * li) / den);
            ((float*)(ws + WS_ATAB))[it] = (float)ar; ((float*)(ws + WS_ATAB))[4096 + it] = (float)ai;
            double pr = ar, pi = ai;
#pragma unroll
            for (int s = 0; s < 7; ++s) { const double t = pr * pr - pi * pi; pi = 2.0 * pr * pi; pr = t; }
            ((float*)(ws + WS_A128))[it] = (float)pr; ((float*)(ws + WS_A128))[4096 + it] = (float)pi;
            bf16_t* bb = (bf16_t*)(ws + WS_BBAR); bf16_t* ct = (bf16_t*)(ws + WS_CTAB);
#pragma unroll 4
            for (int p = 0; p < 16; ++p) {
                const float br = args.in[14][(size_t)it * 16 + p], bi = args.in[15][(size_t)it * 16 + p];
                bb[(size_t)((i * 32 + g) * 128 + n) * 16 + p] = f2bf(fr * br - fi * bi); bb[(size_t)((i * 32 + g) * 128 + 64 + n) * 16 + p] = f2bf(fr * bi + fi * br);
                const size_t ci = (size_t)((i * 32 + g) * 16 + p) * 64 + n;
                ct[(size_t)((i * 32 + g) * 16 + p) * 128 + n] = f2bf(args.in[16][ci]); ct[(size_t)((i * 32 + g) * 16 + p) * 128 + 64 + n] = f2bf(-args.in[17][ci]);
            }
        }
        for (int it = gt; it < 2 * 8 * 128 * 128; it += NGT) { const int r = (it >> 7) & 127, c = it & 127; ((bf16_t*)(ws + WS_WM))[it] = c <= r ? f2bf(args.in[22][it]) : (bf16_t)0; }
        for (int m = gw; m < MT; m += NGW) {
            const float* src = m < MP ? args.in[0] + (size_t)m * DM : args.in[1] + (size_t)(m - MP) * DM;
            float s = 0.f;
#pragma unroll
            for (int j = 0; j < 4; ++j) { const f32x4 v = ((const f32x4*)src)[lane + 64 * j]; s += (v[0] * v[0] + v[1] * v[1]) + (v[2] * v[2] + v[3] * v[3]);
                u32x2 w; w.x = cvt_pk_bf16(v[0], v[1]); w.y = cvt_pk_bf16(v[2], v[3]); ((u32x2*)(HB + (size_t)m * DM))[lane + 64 * j] = w; }
            s = wave_sum(s); if (lane < 16) ssq[((size_t)(lane >> 2) * MT + m) * 4 + (lane & 3)] = lane == 0 ? s : 0.f;
        }
    }
    PH_END

    for (int L = 0; L < DBG_LAYERS; ++L) {
        const int i = L >> 1; const bool even = (L & 1) == 0;
        PH_BEGIN
        {
            const int N = even ? 1536 : 2048;
            pg8::Gemm g{HB, (const bf16_t*)(ws + (even ? WS_W1E + i * 3 * MiB : WS_W1O + i * 4 * MiB)), MT, N, DM, DM, DM};
            pg8::StaticOrder S; S.init(MT, N, G, bx);
            pg8::EpiProj E{PROJ, PLD, ssq + (size_t)(2 * L) * MT * 16, even ? ssqv + (size_t)i * MT * 8 : nullptr, 1024};
            RUN_GEMM(pg8::EpiProj);
        }
        PH_END
        if (even) {
            PH_BEGIN
#if defined(DBG_NOMIX)
            { for (int it = gt; it < MT * 64; it += NGT) { const int m = it >> 6, c8 = it & 63; *(u32x4*)(MIX + (size_t)m * DM + 8 * c8) = *(const u32x4*)(PROJ + (size_t)m * PLD + 8 * c8); } }
#endif
            {
                MAKE_SC MAKE_GC
                for (int wu = gw; wu < 3840 + 128 + 1024; wu += NGW) {
                    if (wu < 3840) { const int g = wu & 31, bc = wu >> 5, b = bc / 15, c = bc % 15; s5_unit<false>(SC, (LAS float*)wreg, lane, b * SEQ + c * 128, g, false, b, c); }
                    else if (wu < 3968) { const int su = wu - 3840, g = su & 31, sbk = su >> 5; s5_unit<true>(SC, (LAS float*)wreg, lane, MP + 128 * sbk, g, true, 32 * sbk, 0); }
                    else { const int su = wu - 3968, hd = su & 7, bc = su >> 3; sgu_unit(GC, (LAS bf16_t*)wreg, lane, bc * 128, hd); }
                }
                for (int it = gt; it < MSAMP * 64; it += NGT) {
                    const int sr = it >> 6, c8 = it & 63, col = 8 * c8, hd = col >> 6, b = sr >> 2, t = sr & 3;
                    float mix[8], vt[8];
#pragma unroll
                    for (int e = 0; e < 8; ++e) { mix[e] = 0.f; vt[e] = 0.f; }
                    const f32x4 g0 = *(const f32x4*)(GC.gnorm + col), g1 = *(const f32x4*)(GC.gnorm + col + 4);
                    for (int j = 0; j <= t; ++j) {
                        const size_t mj = (size_t)(MP + 4 * b + j); const f32x4 q0 = *(const f32x4*)(GC.ssqv + mj * 4), q1 = *(const f32x4*)(GC.ssqv + ((size_t)MT + mj) * 4); const float rs = rstd_of(((q0[0] + q0[1]) + (q0[2] + q0[3])) + ((q1[0] + q1[1]) + (q1[2] + q1[3])), 1.0f / 512);
                        const u32x4 v = *(const u32x4*)(PROJ + mj * PLD + 1024 + col);
                        float vn[8]; vn[0] = bf_lo(v.x) * rs * g0[0]; vn[1] = bf_hi(v.x) * rs * g0[1]; vn[2] = bf_lo(v.y) * rs * g0[2]; vn[3] = bf_hi(v.y) * rs * g0[3];
                        vn[4] = bf_lo(v.z) * rs * g1[0]; vn[5] = bf_hi(v.z) * rs * g1[1]; vn[6] = bf_lo(v.w) * rs * g1[2]; vn[7] = bf_hi(v.w) * rs * g1[3];
                        const float w = GC.sgu_w[(size_t)(hd * 128 + t) * 128 + j];
#pragma unroll
                        for (int e = 0; e < 8; ++e) { mix[e] += w * vn[e]; vt[e] = vn[e]; }
                    }
                    const float bias = GC.sgu_b[hd * 128 + t]; const size_t m = (size_t)(MP + sr);
                    const u32x4 uu = *(const u32x4*)(PROJ + m * PLD + 512 + col);
                    u32x4 w; w.x = cvt_pk_bf16(bf_lo(uu.x) * (mix[0] + bias), bf_hi(uu.x) * (mix[1] + bias)); w.y = cvt_pk_bf16(bf_lo(uu.y) * (mix[2] + bias), bf_hi(uu.y) * (mix[3] + bias));
                    w.z = cvt_pk_bf16(bf_lo(uu.z) * (mix[4] + bias), bf_hi(uu.z) * (mix[5] + bias)); w.w = cvt_pk_bf16(bf_lo(uu.w) * (mix[6] + bias), bf_hi(uu.w) * (mix[7] + bias));
                    *(u32x4*)(MIX + m * DM + 512 + col) = w;
                    float* sv = GC.s_v + (size_t)sr * 512 + col;
                    *(f32x4*)sv = (f32x4){vt[0], vt[1], vt[2], vt[3]}; *(f32x4*)(sv + 4) = (f32x4){vt[4], vt[5], vt[6], vt[7]};
                }
            }
            PH_END
            PH_BEGIN
            {
                MAKE_SC
                for (int wu = gw; wu < 4096; wu += NGW) { const int g = wu & 31, bc = wu >> 5, b = bc >> 4, c = bc & 15; s5_unit<true>(SC, (LAS float*)wreg, lane, b * SEQ + c * 128, g, false, b, c); }
            }
            PH_END
            PH_BEGIN
#if defined(DBG_NOMIX)
            if (0)
#endif
            {
                pg8::Gemm g{PROJ + 1536, (const bf16_t*)(ws + WS_GLU + i * (MiB / 2)), MT, 512, 512, PLD, 512};
                pg8::StaticOrder S; S.init(MT, 512, G, bx);
                pg8::EpiGlu E{MIX, DM, PROJ + 1536, PLD, args.in[20] + i * 512};
                RUN_GEMM(pg8::EpiGlu);
            }
            PH_END
        } else {
            PH_BEGIN
#if defined(DBG_NOMIX_ODD)
            { for (int it = gt; it < MT * 128; it += NGT) { const int m = it >> 7, c8 = it & 127; *(u32x4*)(MIX + (size_t)m * DM + 8 * c8) = *(const u32x4*)(PROJ + (size_t)m * PLD + 8 * c8); } }
            if (0)
#endif
            {
                const float* spool = args.in[4] + (size_t)i * 128 * 15 * 512; const float* sconv = args.in[5] + (size_t)i * 128 * 2 * 512;
                const float* cw = args.in[28] + i * 3 * 512; const float* cb = args.in[29] + i * 512;
                float* ppool = args.out + O_PPOOL + (size_t)i * 8 * 15 * 512; float* pconv = args.out + O_PCONV + (size_t)i * 8 * 2 * 512;
                float* opool = args.out + O_SPOOL + (size_t)i * 128 * 15 * 512; float* oconv = args.out + O_SCONV + (size_t)i * 128 * 2 * 512;
                for (int it = gt; it < MT * 128; it += NGT) {
                    const int m = it >> 7, c8 = it & 127, col = 8 * c8; const bool samp = m >= MP;
                    const int b = samp ? (m - MP) >> 2 : m >> 11, t = samp ? (m - MP) & 3 : m & 2047;
                    if (col < 512) {
                        const int w = 2 << (col >> 7);
                        float s[8], x0[8];
#pragma unroll
                        for (int e = 0; e < 8; ++e) s[e] = 0.f;
                        int n = 0;
                        if (!samp) {
                            n = t + 1 < w ? t + 1 : w;
                            for (int k0 = 0; k0 < n; k0 += 4) {
                                u32x4 v[4];
#pragma unroll
                                for (int kk = 0; kk < 4; ++kk) { const int k = k0 + kk < n ? k0 + kk : 0; v[kk] = *(const u32x4*)(PROJ + (size_t)(m - k) * PLD + col); }
#pragma unroll
                                for (int kk = 0; kk < 4; ++kk) { const float f0 = bf_lo(v[kk].x), f1 = bf_hi(v[kk].x), f2 = bf_lo(v[kk].y), f3 = bf_hi(v[kk].y), f4 = bf_lo(v[kk].z), f5 = bf_hi(v[kk].z), f6 = bf_lo(v[kk].w), f7 = bf_hi(v[kk].w);
                                    if (k0 + kk == 0) { x0[0] = f0; x0[1] = f1; x0[2] = f2; x0[3] = f3; x0[4] = f4; x0[5] = f5; x0[6] = f6; x0[7] = f7; }
                                    if (k0 + kk < n) { s[0] += f0; s[1] += f1; s[2] += f2; s[3] += f3; s[4] += f4; s[5] += f5; s[6] += f6; s[7] += f7; } }
                            }
                        } else
                        for (int k = 0; k < w; ++k) {
                            const int p = t - k;
                            if (p >= 0) { const u32x4 v = *(const u32x4*)(PROJ + (size_t)(m - k) * PLD + col);
                                float f[8]; f[0] = bf_lo(v.x); f[1] = bf_hi(v.x); f[2] = bf_lo(v.y); f[3] = bf_hi(v.y); f[4] = bf_lo(v.z); f[5] = bf_hi(v.z); f[6] = bf_lo(v.w); f[7] = bf_hi(v.w);
#pragma unroll
                                for (int e = 0; e < 8; ++e) { s[e] += f[e]; if (k == 0) x0[e] = f[e]; }
                                ++n; }
                            else if (samp) { const float* q = spool + (size_t)(b * 15 + 15 + p) * 512 + col; const f32x4 a0 = *(const f32x4*)q, a1 = *(const f32x4*)(q + 4);
                                s[0] += a0[0]; s[1] += a0[1]; s[2] += a0[2]; s[3] += a0[3]; s[4] += a1[0]; s[5] += a1[1]; s[6] += a1[2]; s[7] += a1[3]; ++n; }
                        }
                        const float inv = 1.0f / (float)n;
                        u32x4 o; o.x = cvt_pk_bf16(s[0] * inv - x0[0], s[1] * inv - x0[1]); o.y = cvt_pk_bf16(s[2] * inv - x0[2], s[3] * inv - x0[3]);
                        o.z = cvt_pk_bf16(s[4] * inv - x0[4], s[5] * inv - x0[5]); o.w = cvt_pk_bf16(s[6] * inv - x0[6], s[7] * inv - x0[7]);
                        *(u32x4*)(MIX + (size_t)m * DM + col) = o;
                        if (!samp) { if (t >= SEQ - 15) { float* q = ppool + (size_t)(b * 15 + t - (SEQ - 15)) * 512 + col; *(f32x4*)q = (f32x4){x0[0], x0[1], x0[2], x0[3]}; *(f32x4*)(q + 4) = (f32x4){x0[4], x0[5], x0[6], x0[7]}; } }
                        else { float* q = opool + (size_t)(b * 15 + 11 + t) * 512 + col; *(f32x4*)q = (f32x4){x0[0], x0[1], x0[2], x0[3]}; *(f32x4*)(q + 4) = (f32x4){x0[4], x0[5], x0[6], x0[7]};
                            if (t == 0) for (int r = 0; r < 11; ++r) { const float* sp = spool + (size_t)(b * 15 + r + 4) * 512 + col; float* dp = opool + (size_t)(b * 15 + r) * 512 + col;
                                *(f32x4*)dp = *(const f32x4*)sp; *(f32x4*)(dp + 4) = *(const f32x4*)(sp + 4); } }
                    } else {
                        const int d = col - 512;
                        float z[3][8];
#pragma unroll
                        for (int k = 0; k < 3; ++k) {
                            const int p = t - k;
                            if (p >= 0) { const u32x4 xv = *(const u32x4*)(PROJ + (size_t)(m - k) * PLD + 512 + d), cv = *(const u32x4*)(PROJ + (size_t)(m - k) * PLD + 1536 + d);
                                z[k][0] = bf_lo(xv.x) * bf_lo(cv.x); z[k][1] = bf_hi(xv.x) * bf_hi(cv.x); z[k][2] = bf_lo(xv.y) * bf_lo(cv.y); z[k][3] = bf_hi(xv.y) * bf_hi(cv.y);
                                z[k][4] = bf_lo(xv.z) * bf_lo(cv.z); z[k][5] = bf_hi(xv.z) * bf_hi(cv.z); z[k][6] = bf_lo(xv.w) * bf_lo(cv.w); z[k][7] = bf_hi(xv.w) * bf_hi(cv.w); }
                            else if (samp) { const float* q = sconv + (size_t)(b * 2 + 2 + p) * 512 + d; const f32x4 a0 = *(const f32x4*)q, a1 = *(const f32x4*)(q + 4);
                                z[k][0] = a0[0]; z[k][1] = a0[1]; z[k][2] = a0[2]; z[k][3] = a0[3]; z[k][4] = a1[0]; z[k][5] = a1[1]; z[k][6] = a1[2]; z[k][7] = a1[3]; }
                            else {
#pragma unroll
                                for (int e = 0; e < 8; ++e) z[k][e] = 0.f; }
                        }
                        const u32x4 bg = *(const u32x4*)(PROJ + (size_t)m * PLD + 1024 + d);
                        float bgf[8]; bgf[0] = bf_lo(bg.x); bgf[1] = bf_hi(bg.x); bgf[2] = bf_lo(bg.y); bgf[3] = bf_hi(bg.y); bgf[4] = bf_lo(bg.z); bgf[5] = bf_hi(bg.z); bgf[6] = bf_lo(bg.w); bgf[7] = bf_hi(bg.w);
                        float y[8];
#pragma unroll
                        for (int e = 0; e < 8; ++e) y[e] = bgf[e] * (cb[d + e] + z[2][e] * cw[d + e] + z[1][e] * cw[512 + d + e] + z[0][e] * cw[1024 + d + e]);
                        u32x4 o; o.x = cvt_pk_bf16(y[0], y[1]); o.y = cvt_pk_bf16(y[2], y[3]); o.z = cvt_pk_bf16(y[4], y[5]); o.w = cvt_pk_bf16(y[6], y[7]);
                        *(u32x4*)(MIX + (size_t)m * DM + col) = o;
                        float* q = nullptr;
                        if (!samp) { if (t >= SEQ - 2) q = pconv + (size_t)(b * 2 + t - (SEQ - 2)) * 512 + d; } else { if (t >= 2) q = oconv + (size_t)(b * 2 + t - 2) * 512 + d; }
                        if (q) { *(f32x4*)q = (f32x4){z[0][0], z[0][1], z[0][2], z[0][3]}; *(f32x4*)(q + 4) = (f32x4){z[0][4], z[0][5], z[0][6], z[0][7]}; }
                    }
                }
            }
            PH_END
        }
        PH_BEGIN
        {
            pg8::Gemm g{MIX, (const bf16_t*)(ws + (even ? WS_WOE : WS_WOO) + i * 2 * MiB), MT, DM, DM, DM, DM};
            pg8::StaticOrder S; S.init(MT, DM, G, bx);
            pg8::EpiResid E{H, HB, ssq + (size_t)(2 * L + 1) * MT * 16, L == 0 ? args.in[0] : nullptr, L == 0 ? args.in[1] : nullptr};
            RUN_GEMM(pg8::EpiResid);
        }
        PH_END
        PH_BEGIN
        {
            pg8::Gemm g{HB, (const bf16_t*)(ws + WS_WGU + L * 11 * MiB), MT, NGU, DM, DM, DM};
            pg8::StaticOrder S; S.init(MT, NGU, G, bx);
            pg8::EpiSwiglu E{ACT, ssq + (size_t)(2 * L + 1) * MT * 16};
            RUN_GEMM(pg8::EpiSwiglu);
        }
        PH_END
        PH_BEGIN
        {
            pg8::Gemm g{ACT, (const bf16_t*)(ws + WS_WD + L * (11 * MiB / 2)), MT, DM, FF, FF, FF};
            pg8::StaticOrder S; S.init(MT, DM, G, bx);
            pg8::EpiResid E{H, HB, ssq + (size_t)(2 * L + 2) * MT * 16, nullptr, nullptr};
            RUN_GEMM(pg8::EpiResid);
        }
        PH_END
    }
    PH_BEGIN
    {
        const float* sq = ssq + (size_t)8 * MT * 16; const f32x4* gf = (const f32x4*)args.in[8];
        for (int it = gt; it < MT * 256; it += NGT) { const int m = it >> 8, c4 = it & 255; const f32x4* q = (const f32x4*)sq + m; const f32x4 qa = q[0], qb = q[(size_t)MT], qc = q[(size_t)2 * MT], qd = q[(size_t)3 * MT];
            const float rs = rstd_of((((qa[0] + qa[1]) + (qa[2] + qa[3])) + ((qb[0] + qb[1]) + (qb[2] + qb[3]))) + (((qc[0] + qc[1]) + (qc[2] + qc[3])) + ((qd[0] + qd[1]) + (qd[2] + qd[3]))), 1.0f / DM);
            f32x4 v = ((f32x4*)H)[it]; const f32x4 gg = gf[c4]; v = v * rs * gg; ((f32x4*)H)[it] = v; }
    }
    PH_END
    if (hi - lo > 1) grid.sync();
#if defined(DBG_MASK)
    PH_BEGIN
    {
        float* o = args.out; (void)ws;
        for (size_t it = (size_t)gt; it < O_END; it += NGT) {
            int cls;
            if (it < (size_t)MP * DM) cls = 0; else if (it < O_PRE) cls = 1; else if (it < O_PPOOL) cls = 2; else if (it < O_SRE) cls = 3; else if (it < O_SV) cls = 2; else if (it < O_SPOOL) cls = 4; else cls = 3;
            if ((DBG_MASK >> cls) & 1) o[it] = 0.f;
        }
    }
    PH_END
#endif
#undef PH_BEGIN
#undef PH_END
#if defined(DBG_STOP)
    if (lo == 99) {
        const int tid = threadIdx.x; unsigned char* ws = args.ws; float* o = args.out + O_SPOOL;
        const int NEL = (int)(O_END - O_SPOOL);
        for (int it = bx * 512 + tid; it < NEL; it += NGT) {
            float v;
            if (DBG_SRC == 0) { const int r = it >> 10, c = it & 1023; const int row = MP + (r % MSAMP); v = bf1(f2bf(args.out[(size_t)row * DM + c])); }
            else if (DBG_SRC == 1) { const int r = it >> 11, c = it & 2047; const int row = MP + (r % MSAMP); v = bf1(((const bf16_t*)(ws + WS_PROJ))[(size_t)row * PLD + c]); }
            else if (DBG_SRC == 2) { const int r = it >> 10, c = it & 1023; const int row = MP + (r % MSAMP); v = bf1(((const bf16_t*)(ws + WS_MIX))[(size_t)row * DM + c]); }
            else if (DBG_SRC == 5) { const int r = (it >> 11) % MSAMP, c = it & 2047; if (it >= MSAMP * 2048) { o[it] = 0.f; continue; }
                const bf16_t* a = (const bf16_t*)(ws + WS_HB) + (size_t)(MP + r) * DM; const bf16_t* w = (const bf16_t*)(ws + WS_W1O + 4 * MiB) + (size_t)c * DM; float acc = 0.f;
                for (int k = 0; k < DM; ++k) acc += bf1(a[k]) * bf1(w[k]);
                v = bf1(f2bf(acc)); }
            else if (DBG_SRC == 4) { const int r = it >> 10, c = it & 1023; const int row = MP + (r % MSAMP); v = bf1(((const bf16_t*)(ws + WS_HB))[(size_t)row * DM + c]); }
            else { const int r = it / FF, c = it % FF; const int row = MP + (r % MSAMP); v = bf1(((const bf16_t*)(ws + WS_ACT))[(size_t)row * FF + c]); }
            o[it] = v;
        }
    }
#endif
}

#if defined(DBG_MASK)
constexpr int N_PHASES = 1 + 2 * 7 + 2 * 5 + 2;
#else
constexpr int N_PHASES = 1 + 2 * 7 + 2 * 5 + 1;
#endif

extern "C" void kernel_launch(void* const* d_in, const int* in_sizes, int n_in, void* d_out, int out_size, void* d_ws, size_t ws_size, hipStream_t stream) {
    static int grid = 0;
    if (grid == 0) {
        if (n_in != 33 || out_size != (int)O_END || ws_size < WS_END) { fprintf(stderr, "kernel_launch: unexpected shapes n_in %d out %d ws %zu\n", n_in, out_size, ws_size); grid = -1; return; }
        int dev = 0, cus = 0, per_cu = 0;
        hipGetDevice(&dev); hipDeviceGetAttribute(&cus, hipDeviceAttributeMultiprocessorCount, dev);
        hipFuncSetAttribute((const void*)fwd_megakernel, hipFuncAttributeMaxDynamicSharedMemorySize, LDS_BYTES);
        hipOccupancyMaxActiveBlocksPerMultiprocessor(&per_cu, (const void*)fwd_megakernel, 512, LDS_BYTES);
        if (per_cu < 1) { fprintf(stderr, "kernel_launch: occupancy query says %d blocks per CU\n", per_cu); per_cu = 1; }
        (void)hipGetLastError();
        grid = cus;
    }
    if (grid < 0) return;
#if defined(DBG_FILLWS)
    (void)hipMemsetAsync((char*)d_ws + DBG_F0 * MiB, 0, (size_t)(DBG_F1 - DBG_F0) * MiB, stream); (void)hipMemsetAsync(d_out, 0, O_END * 4, stream);
#endif
#if defined(DBG_TINYSET)
    (void)hipMemsetAsync((char*)d_ws + 255 * MiB, 0, 256, stream); (void)hipMemsetAsync((char*)d_ws + 255 * MiB + 4096, 0, 256, stream);
#endif
    (void)hipMemsetAsync((char*)d_ws + WS_BAR, 0, 256, stream);
    Args a{};
    for (int i = 0; i < 33; ++i) a.in[i] = (const float*)d_in[i];
    a.out = (float*)d_out; a.ws = (unsigned char*)d_ws;
#if MK_PER_PHASE
#if defined(DBG_STOP)
    for (int p = 0; p < DBG_STOP; ++p) { a.ph_lo = p; a.ph_hi = p + 1; hipLaunchKernelGGL(fwd_megakernel, dim3(grid), dim3(512), LDS_BYTES, stream, a); }
    a.ph_lo = 99; a.ph_hi = 100; hipLaunchKernelGGL(fwd_megakernel, dim3(grid), dim3(512), LDS_BYTES, stream, a);
#else
    for (int p = 0; p < N_PHASES; ++p) { a.ph_lo = p; a.ph_hi = p + 1; hipLaunchKernelGGL(fwd_megakernel, dim3(grid), dim3(512), LDS_BYTES, stream, a); }
#endif
#else
    a.ph_lo = 0; a.ph_hi = N_PHASES;
    void* kargs[] = {&a};
    hipError_t e = hipLaunchCooperativeKernel((const void*)fwd_megakernel, dim3(grid), dim3(512), kargs, LDS_BYTES, stream);
    if (e != hipSuccess) fprintf(stderr, "cooperative launch failed: %s (grid %d)\n", hipGetErrorString(e), grid);
#endif
}
```
